# Optimizing an MI355X kernel written in HIP

```python
import math
import jax, jax.numpy as jnp
from jax import lax
import numpy as np

D_MODEL = 1024
BATCH = 8
SEQ = 4096
DEPTH = 4

CTX_LEN = 256
GRID_W = 64
N_MIXERS = 4
Q_BLOCK = 128
ROPE_THETA = 10000.0
NORM_EPS = 1e-6
N_MOD = 9
D_FF = 2816
NEG_INF = -1e30

DA_QK_DIM = 64
DA_HEADS = D_MODEL // (2 * DA_QK_DIM)
DA_V_DIM = 2 * DA_QK_DIM
DA_QKV = 2 * DA_HEADS * 2 * DA_QK_DIM + DA_HEADS * DA_V_DIM
GA_HEAD_DIM = 128
GA_HEADS = D_MODEL // GA_HEAD_DIM
GA_KV_HEADS = 2
MLA_HEADS = 16
MLA_Q_RANK = 256
MLA_KV_RANK = 128
MLA_NOPE_DIM = 64
MLA_ROPE_DIM = 32
MLA_V_DIM = 64
SWA_HEAD_DIM = 64
SWA_HEADS = D_MODEL // SWA_HEAD_DIM
SWA_KV_HEADS = 2
WINDOW = 128
BAND = Q_BLOCK + 2 * WINDOW

kernel_name = "hybrid_interleaved_diffusion_trunk"


def rmsnorm(x, g):
    xf = x.astype(jnp.float32)
    y = xf * lax.rsqrt(jnp.mean(xf * xf, axis=-1, keepdims=True) + NORM_EPS)
    return (y * g.astype(jnp.float32)).astype(x.dtype)


def axial_rope_tables(seq_len, rot_dim):
    rows = seq_len // GRID_W
    row = jnp.repeat(jnp.arange(rows, dtype=jnp.int32), GRID_W).astype(jnp.float32)
    col = jnp.tile(jnp.arange(GRID_W, dtype=jnp.int32), rows).astype(jnp.float32)
    n_axis = rot_dim // 4
    freqs = ROPE_THETA ** (-jnp.arange(n_axis, dtype=jnp.float32) / n_axis)
    ang = jnp.concatenate([row[:, None] * freqs, col[:, None] * freqs], axis=-1)
    return jnp.cos(ang), jnp.sin(ang)


def apply_rope(x, cos, sin):
    seq, half = cos.shape
    bshape = (seq,) + (1,) * (x.ndim - 3) + (half,)
    cs = cos.reshape(bshape).astype(x.dtype)
    sn = sin.reshape(bshape).astype(x.dtype)
    xp = x.reshape(x.shape[:-1] + (half, 2))
    x0, x1 = xp[..., 0], xp[..., 1]
    return jnp.stack([x0 * cs - x1 * sn, x0 * sn + x1 * cs], axis=-1).reshape(x.shape)


def sweep_query_blocks(fn, *qs):
    b, s = qs[0].shape[:2]
    nblk = s // Q_BLOCK
    blocks = tuple(jnp.moveaxis(q.reshape((b, nblk, Q_BLOCK) + q.shape[2:]), 1, 0) for q in qs)
    out = lax.map(lambda args: fn(*args), (jnp.arange(nblk),) + blocks)
    return jnp.moveaxis(out, 0, 1).reshape((b, s) + out.shape[3:])


def grouped_attend(q, k, v, scale):
    s = jnp.einsum('blhgd,bkhd->bhglk', q, k, preferred_element_type=jnp.float32) * scale
    p = jax.nn.softmax(s, axis=-1)
    o = jnp.einsum('bhglk,bkhd->blhgd', p.astype(v.dtype), v)
    return o.reshape(o.shape[:2] + (-1,))


def swiglu(h, w_in, w_out):
    gate, up = jnp.split(h @ w_in, 2, axis=-1)
    return (jax.nn.silu(gate) * up) @ w_out


def adaln(cond, w, b):
    m = jax.nn.silu(cond) @ w + b
    return m.reshape(m.shape[:-1] + (N_MOD, D_MODEL))


def modulated_norm(h, g, m, k):
    return rmsnorm(h, g) * (1.0 + m[..., k + 1, :]) + m[..., k, :]


def gated_residual(h, y, g, m, k, weight):
    return h + weight * m[..., k + 2, :] * rmsnorm(y, g)


def half_ffn(h, m, k, g_pre, g_post, w_in, w_out):
    y = swiglu(modulated_norm(h, g_pre, m, k), w_in, w_out)
    return gated_residual(h, y, g_post, m, k, 0.5)


def diff_attention_mixer(h, hc, w_in, lam, subln, w_out, lambda_init, ctx_out):
    b, s, _ = h.shape
    cos, sin = axial_rope_tables(s, DA_QK_DIM)

    def project(t):
        n = t.shape[1]
        q, k, v = jnp.split(t @ w_in, [DA_HEADS * 2 * DA_QK_DIM, 2 * DA_HEADS * 2 * DA_QK_DIM], axis=-1)
        return (q.reshape(b, n, DA_HEADS, 2, DA_QK_DIM), k.reshape(b, n, DA_HEADS, 2, DA_QK_DIM),
                v.reshape(b, n, DA_HEADS, DA_V_DIM))

    q, k, v = project(h)
    qc, kc, vc = project(hc)
    q, k = apply_rope(q, cos, sin), apply_rope(k, cos, sin)
    lf = lam.astype(jnp.float32)
    lam_full = jnp.exp(jnp.sum(lf[0] * lf[1])) - jnp.exp(jnp.sum(lf[2] * lf[3])) + lambda_init
    scale = DA_QK_DIM ** -0.5

    def attend(qb, kb, vb):
        sc = jnp.einsum('blhid,bkhid->bihlk', qb, kb, preferred_element_type=jnp.float32) * scale
        p = jax.nn.softmax(sc, axis=-1)
        p = p[:, 0] - lam_full * p[:, 1]
        o = jnp.einsum('bhlk,bkhd->blhd', p.astype(vb.dtype), vb)
        o = rmsnorm(o, subln) * (1.0 - lambda_init)
        return o.reshape(o.shape[0], o.shape[1], DA_HEADS * DA_V_DIM)

    k_all = jnp.concatenate([kc, k], axis=1)
    v_all = jnp.concatenate([vc, v], axis=1)
    y = sweep_query_blocks(lambda i, qb: attend(qb, k_all, v_all), q) @ w_out
    yc = attend(qc, kc, vc) @ w_out if ctx_out else None
    return y, yc


def gqa_axial_mixer(h, hc, w_in, q_norm, k_norm, w_out, ctx_out):
    b, s, _ = h.shape
    cos, sin = axial_rope_tables(s, GA_HEAD_DIM)
    grp = GA_HEADS // GA_KV_HEADS

    def project(t):
        n = t.shape[1]
        q, k, v = jnp.split(t @ w_in, [GA_HEADS * GA_HEAD_DIM, (GA_HEADS + GA_KV_HEADS) * GA_HEAD_DIM], axis=-1)
        q = rmsnorm(q.reshape(b, n, GA_KV_HEADS, grp, GA_HEAD_DIM), q_norm)
        k = rmsnorm(k.reshape(b, n, GA_KV_HEADS, GA_HEAD_DIM), k_norm)
        return q, k, v.reshape(b, n, GA_KV_HEADS, GA_HEAD_DIM)

    q, k, v = project(h)
    qc, kc, vc = project(hc)
    q, k = apply_rope(q, cos, sin), apply_rope(k, cos, sin)
    scale = GA_HEAD_DIM ** -0.5
    k_all = jnp.concatenate([kc, k], axis=1)
    v_all = jnp.concatenate([vc, v], axis=1)
    y = sweep_query_blocks(lambda i, qb: grouped_attend(qb, k_all, v_all, scale), q) @ w_out
    yc = grouped_attend(qc, kc, vc, scale) @ w_out if ctx_out else None
    return y, yc


def mla_mixer(h, hc, w_in, q_norm, kv_norm, w_uq, w_ukv, w_out, ctx_out):
    b, s, _ = h.shape
    cos, sin = axial_rope_tables(s, MLA_ROPE_DIM)

    def project(t):
        n = t.shape[1]
        cq, ckv, kr = jnp.split(t @ w_in, [MLA_Q_RANK, MLA_Q_RANK + MLA_KV_RANK], axis=-1)
        q = (rmsnorm(cq, q_norm) @ w_uq).reshape(b, n, MLA_HEADS, MLA_NOPE_DIM + MLA_ROPE_DIM)
        kv = (rmsnorm(ckv, kv_norm) @ w_ukv).reshape(b, n, MLA_HEADS, MLA_NOPE_DIM + MLA_V_DIM)
        qn, qr = jnp.split(q, [MLA_NOPE_DIM], axis=-1)
        kn, v = jnp.split(kv, [MLA_NOPE_DIM], axis=-1)
        return qn, qr, kn, kr, v

    qn, qr, kn, kr, v = project(h)
    qnc, qrc, knc, krc, vc = project(hc)
    qr, kr = apply_rope(qr, cos, sin), apply_rope(kr, cos, sin)
    scale = (MLA_NOPE_DIM + MLA_ROPE_DIM) ** -0.5

    def attend(qnb, qrb, knb, krb, vb):
        sc = (jnp.einsum('blhd,bkhd->bhlk', qnb, knb, preferred_element_type=jnp.float32)
              + jnp.einsum('blhd,bkd->bhlk', qrb, krb, preferred_element_type=jnp.float32)) * scale
        p = jax.nn.softmax(sc, axis=-1)
        o = jnp.einsum('bhlk,bkhd->blhd', p.astype(vb.dtype), vb)
        return o.reshape(o.shape[0], o.shape[1], MLA_HEADS * MLA_V_DIM)

    kn_all = jnp.concatenate([knc, kn], axis=1)
    kr_all = jnp.concatenate([krc, kr], axis=1)
    v_all = jnp.concatenate([vc, v], axis=1)
    y = sweep_query_blocks(lambda i, a, r: attend(a, r, kn_all, kr_all, v_all), qn, qr) @ w_out
    yc = attend(qnc, qrc, knc, krc, vc) @ w_out if ctx_out else None
    return y, yc


def window_sink_mixer(h, hc, w_in, sink, w_out, ctx_out):
    b, s, _ = h.shape
    cos, sin = axial_rope_tables(s, SWA_HEAD_DIM)
    grp = SWA_HEADS // SWA_KV_HEADS

    def project(t):
        n = t.shape[1]
        q, k, v = jnp.split(t @ w_in, [SWA_HEADS * SWA_HEAD_DIM, (SWA_HEADS + SWA_KV_HEADS) * SWA_HEAD_DIM], axis=-1)
        return (q.reshape(b, n, SWA_KV_HEADS, grp, SWA_HEAD_DIM), k.reshape(b, n, SWA_KV_HEADS, SWA_HEAD_DIM),
                v.reshape(b, n, SWA_KV_HEADS, SWA_HEAD_DIM))

    q, k, v = project(h)
    qc, kc, vc = project(hc)
    q, k = apply_rope(q, cos, sin), apply_rope(k, cos, sin)
    scale = SWA_HEAD_DIM ** -0.5
    sink_l = sink.astype(jnp.float32).reshape(SWA_KV_HEADS, grp)[None, :, :, None, None]

    def sink_softmax_mix(sc, vals):
        sc = jnp.concatenate([sc, jnp.broadcast_to(sink_l, sc.shape[:-1] + (1,))], axis=-1)
        p = jax.nn.softmax(sc, axis=-1)[..., :-1]
        o = jnp.einsum('bhglk,bkhd->blhgd', p.astype(vals.dtype), vals)
        return o.reshape(o.shape[:2] + (-1,))

    pad = ((0, 0), (WINDOW, WINDOW), (0, 0), (0, 0))
    k_pad, v_pad = jnp.pad(k, pad), jnp.pad(v, pad)

    def latent_block(i, qb):
        start = i * Q_BLOCK
        kb = lax.dynamic_slice_in_dim(k_pad, start, BAND, axis=1)
        vb = lax.dynamic_slice_in_dim(v_pad, start, BAND, axis=1)
        qpos = start + jnp.arange(Q_BLOCK)
        kpos = start - WINDOW + jnp.arange(BAND)
        allowed = (kpos[None, :] >= 0) & (kpos[None, :] < s) & (jnp.abs(qpos[:, None] - kpos[None, :]) <= WINDOW)
        s_band = jnp.einsum('blhgd,bkhd->bhglk', qb, kb, preferred_element_type=jnp.float32) * scale
        s_band = jnp.where(allowed, s_band, NEG_INF)
        s_ctx = jnp.einsum('blhgd,bkhd->bhglk', qb, kc, preferred_element_type=jnp.float32) * scale
        return sink_softmax_mix(jnp.concatenate([s_ctx, s_band], axis=-1), jnp.concatenate([vc, vb], axis=1))

    y = sweep_query_blocks(latent_block, q) @ w_out
    yc = None
    if ctx_out:
        s_cc = jnp.einsum('blhgd,bkhd->bhglk', qc, kc, preferred_element_type=jnp.float32) * scale
        yc = sink_softmax_mix(s_cc, vc) @ w_out
    return y, yc


def setup_inputs(seed: int = 0) -> dict:
    key = jax.random.key(seed)
    ks = iter(jax.random.split(key, 32))
    f32 = jnp.float32

    def nrm(shape, scale=1.0):
        return jax.random.normal(next(ks), shape, f32) * scale

    def w(shape, fan_in):
        return nrm(shape, fan_in ** -0.5)

    def gain(shape):
        return 1.0 + nrm(shape, 0.02)

    n0, n1, n2, n3 = [len(range(k, DEPTH, N_MIXERS)) for k in range(N_MIXERS)]
    return {
        "x": nrm((BATCH, SEQ, D_MODEL)),
        "c": nrm((BATCH, D_MODEL)),
        "ctx": nrm((BATCH, CTX_LEN, D_MODEL)),
        "c_ctx": nrm((D_MODEL,)),
        "ada_w": w((DEPTH, D_MODEL, N_MOD * D_MODEL), D_MODEL),
        "ada_b": nrm((DEPTH, N_MOD * D_MODEL), 0.02),
        "norm_g": gain((DEPTH, 6, D_MODEL)),
        "ffn_w_in": w((DEPTH, 2, D_MODEL, 2 * D_FF), D_MODEL),
        "ffn_w_out": w((DEPTH, 2, D_FF, D_MODEL), D_FF),
        "da_w_in": w((n0, D_MODEL, DA_QKV), D_MODEL),
        "da_lambda": nrm((n0, 4, DA_QK_DIM), 0.1),
        "da_subln": gain((n0, DA_V_DIM)),
        "da_w_out": w((n0, DA_HEADS * DA_V_DIM, D_MODEL), DA_HEADS * DA_V_DIM),
        "ga_w_in": w((n1, D_MODEL, (GA_HEADS + 2 * GA_KV_HEADS) * GA_HEAD_DIM), D_MODEL),
        "ga_q_norm": gain((n1, GA_HEAD_DIM)),
        "ga_k_norm": gain((n1, GA_HEAD_DIM)),
        "ga_w_out": w((n1, GA_HEADS * GA_HEAD_DIM, D_MODEL), GA_HEADS * GA_HEAD_DIM),
        "mla_w_in": w((n2, D_MODEL, MLA_Q_RANK + MLA_KV_RANK + MLA_ROPE_DIM), D_MODEL),
        "mla_q_norm": gain((n2, MLA_Q_RANK)),
        "mla_kv_norm": gain((n2, MLA_KV_RANK)),
        "mla_w_uq": w((n2, MLA_Q_RANK, MLA_HEADS * (MLA_NOPE_DIM + MLA_ROPE_DIM)), MLA_Q_RANK),
        "mla_w_ukv": w((n2, MLA_KV_RANK, MLA_HEADS * (MLA_NOPE_DIM + MLA_V_DIM)), MLA_KV_RANK),
        "mla_w_out": w((n2, MLA_HEADS * MLA_V_DIM, D_MODEL), MLA_HEADS * MLA_V_DIM),
        "swa_w_in": w((n3, D_MODEL, (SWA_HEADS + 2 * SWA_KV_HEADS) * SWA_HEAD_DIM), D_MODEL),
        "swa_sink": nrm((n3, SWA_HEADS), 0.5),
        "swa_w_out": w((n3, SWA_HEADS * SWA_HEAD_DIM, D_MODEL), SWA_HEADS * SWA_HEAD_DIM),
    }


def reference(x, c, ctx, c_ctx, ada_w, ada_b, norm_g, ffn_w_in, ffn_w_out,
              da_w_in, da_lambda, da_subln, da_w_out,
              ga_w_in, ga_q_norm, ga_k_norm, ga_w_out,
              mla_w_in, mla_q_norm, mla_kv_norm, mla_w_uq, mla_w_ukv, mla_w_out,
              swa_w_in, swa_sink, swa_w_out):
    h, hc = x, ctx
    for i in range(DEPTH):
        kind, occ = i % N_MIXERS, i // N_MIXERS
        ctx_out = i < DEPTH - 1
        m = adaln(c, ada_w[i], ada_b[i])[:, None]
        mc = adaln(c_ctx, ada_w[i], ada_b[i])[None]
        g = norm_g[i]
        h = half_ffn(h, m, 0, g[0], g[1], ffn_w_in[i, 0], ffn_w_out[i, 0])
        hc = half_ffn(hc, mc, 0, g[0], g[1], ffn_w_in[i, 0], ffn_w_out[i, 0])
        u = modulated_norm(h, g[2], m, 3)
        uc = modulated_norm(hc, g[2], mc, 3)
        if kind == 0:
            lambda_init = 0.8 - 0.6 * math.exp(-0.3 * i)
            y, yc = diff_attention_mixer(u, uc, da_w_in[occ], da_lambda[occ], da_subln[occ], da_w_out[occ],
                                         lambda_init, ctx_out)
        elif kind == 1:
            y, yc = gqa_axial_mixer(u, uc, ga_w_in[occ], ga_q_norm[occ], ga_k_norm[occ], ga_w_out[occ], ctx_out)
        elif kind == 2:
            y, yc = mla_mixer(u, uc, mla_w_in[occ], mla_q_norm[occ], mla_kv_norm[occ], mla_w_uq[occ],
                              mla_w_ukv[occ], mla_w_out[occ], ctx_out)
        else:
            y, yc = window_sink_mixer(u, uc, swa_w_in[occ], swa_sink[occ], swa_w_out[occ], ctx_out)
        h = gated_residual(h, y, g[3], m, 3, 1.0)
        h = half_ffn(h, m, 6, g[4], g[5], ffn_w_in[i, 1], ffn_w_out[i, 1])
        if ctx_out:
            hc = gated_residual(hc, yc, g[3], mc, 3, 1.0)
            hc = half_ffn(hc, mc, 6, g[4], g[5], ffn_w_in[i, 1], ffn_w_out[i, 1])
    return h
```

```cpp
#include <hip/hip_runtime.h>
#include <hip/hip_cooperative_groups.h>
#include <cstdio>
#include <cstdint>
#include <cmath>
namespace cg = cooperative_groups;
__device__ __forceinline__ int tid_opaque() { int t = threadIdx.x; asm volatile("" : "+v"(t)); return t; }
__device__ __forceinline__ int bid_opaque() { int b = blockIdx.x; asm volatile("" : "+s"(b)); return b; }
namespace pg8 {
#define PG8_LAS __attribute__((address_space(3)))
typedef unsigned short bf16_t;
typedef short bf16x8 __attribute__((ext_vector_type(8)));
typedef float f32x4 __attribute__((ext_vector_type(4)));
typedef unsigned u32x4 __attribute__((ext_vector_type(4)));
constexpr int BM = 256, BK = 64, HALF = 128, HTB = HALF * BK * 2  , STAGE_BYTES = 8 * HTB, NXCD = 8, WGM = 8;

__host__ __device__ __forceinline__ int lds_byte(int r, int c) { const int st = (r >> 4) * 2 + (c >> 5), rr = r & 15, cc = c & 31, ob = rr * 64 + cc * 2; return st * 1024 + (ob ^ (((ob >> 9) & 1) << 5)); }
__host__ __device__ __forceinline__ void stage_rc(int b, int& R, int& C) { const int st = b / 1024, sb = b % 1024, swz = sb ^ (((sb >> 9) & 1) << 5); R = (st >> 1) * 16 + swz / 64; C = (st & 1) * 32 + (swz % 64) / 2; }
__host__ __device__ __forceinline__ int perm32(int rho) { const int n = rho >> 4, i = rho & 15; return 8 * (i >> 2) + 4 * n + (i & 3); }

struct Unit { int pm, pn; };
struct Gemm { const bf16_t* A; const bf16_t* Bt; int M, N, K; };

struct StaticOrder {
    int nM, nN, nwg, G, c;
    __host__ __device__ void init(int M, int N, int G_, int c_) { nM = M / BM; nN = N / BM; nwg = nM * nN; G = G_; c = c_; }
    __host__ __device__ bool next(int i, Unit& u) const {
        const long L = (long)i * G + c; if (L >= nwg) return false;
        int wgid = (int)L; { const int q = nwg / NXCD, r = nwg % NXCD, xcd = wgid % NXCD, off = wgid / NXCD; wgid = (xcd < r ? xcd * (q + 1) : r * (q + 1) + (xcd - r) * q) + off; }
        const int nig = WGM * nN, gid = wgid / nig, fm = gid * WGM, gsz = (nM - fm) < WGM ? (nM - fm) : WGM;
        u.pm = fm + ((wgid % nig) % gsz); u.pn = (wgid % nig) / gsz; return true;
    }
    __device__ __forceinline__ void a_ready(const Unit&) const {}
    __device__ __forceinline__ void done(const Unit&) const {}
};

__device__ __forceinline__ unsigned cvt_pk_bf16(float lo, float hi) { unsigned r; asm volatile("v_cvt_pk_bf16_f32 %0, %1, %2" : "=v"(r) : "v"(lo), "v"(hi)); return r; }
struct EpiBf16S {
    static constexpr bool PERM = true, AFTER_DRAIN = false;
    bf16_t* O; int ldc;
    __device__ __forceinline__ void operator()(const f32x4 (&acc)[2][2][4][2], const Unit& u, int wr, int wc, int fr, int fq) const {
        const int row0 = u.pm * BM + wr * 64 + fr; const int col0 = u.pn * BM + wc * 32 + 8 * fq;
#pragma unroll
        for (int ai = 0; ai < 2; ++ai)
#pragma unroll
            for (int m = 0; m < 4; ++m) { bf16_t* rowp = O + (size_t)(row0 + ai * HALF + m * 16) * ldc + col0;
#pragma unroll
                for (int bj = 0; bj < 2; ++bj) { const f32x4 v0 = acc[ai][bj][m][0], v1 = acc[ai][bj][m][1];
                    u32x4 w; w.x = cvt_pk_bf16(v0[0], v0[1]); w.y = cvt_pk_bf16(v0[2], v0[3]); w.z = cvt_pk_bf16(v1[0], v1[1]); w.w = cvt_pk_bf16(v1[2], v1[3]);
                    *(u32x4*)(rowp + bj * HALF) = w; } }
    }
};
__device__ __forceinline__ float silu_mul(float g, float u) { return g * __builtin_amdgcn_rcpf(1.0f + __builtin_amdgcn_exp2f(-1.4426950408889634f * g)) * u; }
struct EpiSwiGLU {
    static constexpr bool PERM = true, AFTER_DRAIN = false;
    bf16_t* O; int ldc;
    __device__ __forceinline__ void operator()(const f32x4 (&acc)[2][2][4][2], const Unit& u, int wr, int wc, int fr, int fq) const {
        const int row0 = u.pm * BM + wr * 64 + fr; const int col0 = u.pn * HALF + wc * 32 + 8 * fq;
#pragma unroll
        for (int ai = 0; ai < 2; ++ai)
#pragma unroll
            for (int m = 0; m < 4; ++m) { bf16_t* rowp = O + (size_t)(row0 + ai * HALF + m * 16) * ldc + col0;
                const f32x4 g0 = acc[ai][0][m][0], g1 = acc[ai][0][m][1], u0 = acc[ai][1][m][0], u1 = acc[ai][1][m][1];
                u32x4 w;
                w.x = cvt_pk_bf16(silu_mul(g0[0], u0[0]), silu_mul(g0[1], u0[1])); w.y = cvt_pk_bf16(silu_mul(g0[2], u0[2]), silu_mul(g0[3], u0[3]));
                w.z = cvt_pk_bf16(silu_mul(g1[0], u1[0]), silu_mul(g1[1], u1[1])); w.w = cvt_pk_bf16(silu_mul(g1[2], u1[2]), silu_mul(g1[3], u1[3]));
                *(u32x4*)rowp = w; }
    }
};
struct EpiF32 {
    static constexpr bool PERM = false, AFTER_DRAIN = false;
    float* O; int ldc;
    __device__ __forceinline__ void operator()(const f32x4 (&acc)[2][2][4][2], const Unit& u, int wr, int wc, int fr, int fq) const {
        const int col0 = u.pn * BM + wc * 32 + 4 * fq;
#pragma unroll
        for (int ai = 0; ai < 2; ++ai)
#pragma unroll
            for (int m = 0; m < 4; ++m) { float* rowp = O + (size_t)(u.pm * BM + ai * HALF + wr * 64 + m * 16 + fr) * ldc + col0;
#pragma unroll
                for (int bj = 0; bj < 2; ++bj)
#pragma unroll
                    for (int n = 0; n < 2; ++n) *(f32x4*)(rowp + bj * HALF + n * 16) = acc[ai][bj][m][n]; }
    }
};

struct EpiBf16Rope {
    static constexpr bool PERM = true, AFTER_DRAIN = false;
    bf16_t* O; int ldc; int mode; int col_limit; int lat_panels;
    __device__ __forceinline__ void operator()(const f32x4 (&acc)[2][2][4][2], const Unit& u, int wr, int wc, int fr, int fq) const {
        const int row0 = u.pm * BM + wr * 64 + fr; const int col0 = u.pn * BM + wc * 32 + 8 * fq;
        const bool lat = mode != 0 && u.pm < lat_panels;
        bool rot[2]; float fr4[2][4]; bool rowaxis[2];
#pragma unroll
        for (int bj = 0; bj < 2; ++bj) { const int col = col0 + bj * HALF; int j0, nax;
            if (mode == 2) { const int c96 = col % 96; rot[bj] = lat && c96 >= 64; j0 = (c96 - 64) >> 1; nax = 8; }
            else { rot[bj] = lat && col < col_limit; j0 = (col & 63) >> 1; nax = 16; }
            rowaxis[bj] = j0 < nax; const int f0 = j0 & (nax - 1);
#pragma unroll
            for (int e = 0; e < 4; ++e) fr4[bj][e] = __builtin_amdgcn_exp2f(-13.287712379549449f * (float)(f0 + e) / (float)nax); }
#pragma unroll
        for (int ai = 0; ai < 2; ++ai)
#pragma unroll
            for (int m = 0; m < 4; ++m) { const int row = row0 + ai * HALF + m * 16; bf16_t* rowp = O + (size_t)row * ldc + col0;
                const int s = row & 4095; const float prow = (float)(s >> 6), pcol = (float)(s & 63);
#pragma unroll
                for (int bj = 0; bj < 2; ++bj) { f32x4 v0 = acc[ai][bj][m][0], v1 = acc[ai][bj][m][1];
                    if (rot[bj]) { const float pos = rowaxis[bj] ? prow : pcol;
                        float cs, sn, t;
                        cs = __cosf(pos * fr4[bj][0]); sn = __sinf(pos * fr4[bj][0]); t = v0[0] * cs - v0[1] * sn; v0[1] = v0[0] * sn + v0[1] * cs; v0[0] = t;
                        cs = __cosf(pos * fr4[bj][1]); sn = __sinf(pos * fr4[bj][1]); t = v0[2] * cs - v0[3] * sn; v0[3] = v0[2] * sn + v0[3] * cs; v0[2] = t;
                        cs = __cosf(pos * fr4[bj][2]); sn = __sinf(pos * fr4[bj][2]); t = v1[0] * cs - v1[1] * sn; v1[1] = v1[0] * sn + v1[1] * cs; v1[0] = t;
                        cs = __cosf(pos * fr4[bj][3]); sn = __sinf(pos * fr4[bj][3]); t = v1[2] * cs - v1[3] * sn; v1[3] = v1[2] * sn + v1[3] * cs; v1[2] = t; }
                    u32x4 w; w.x = cvt_pk_bf16(v0[0], v0[1]); w.y = cvt_pk_bf16(v0[2], v0[3]); w.z = cvt_pk_bf16(v1[0], v1[1]); w.w = cvt_pk_bf16(v1[2], v1[3]);
                    *(u32x4*)(rowp + bj * HALF) = w; } }
    }
};
template <class Epi, class Sched, bool ALIGN_EPI = false, bool SP2 = false>
__device__ __forceinline__ void gemm_phase(PG8_LAS unsigned char* lds, const Gemm g, const Sched& S, const Epi& E) {
    const int tid = tid_opaque(), wid = __builtin_amdgcn_readfirstlane(tid >> 6), lane = tid & 63, wr = wid >> 2, wc = wid & 3, fr = lane & 15, fq = lane >> 4;
    const int K = g.K, nt = K / BK;
    unsigned voffA[2], voffB[2];
#pragma unroll
    for (int i = 0; i < 2; ++i) { int R, C; stage_rc(tid * 16 + i * 8192, R, C); const int Rb = Epi::PERM ? ((R & ~31) + perm32(R & 31)) : R;
        voffA[i] = (unsigned)(R * K + C) * 2u; voffB[i] = (unsigned)(Rb * K + C) * 2u; }
    const size_t kstep = (size_t)(BK * 2);
    const size_t hstep = (size_t)HALF * K * 2;
    const size_t tstep = 2 * hstep;
    const unsigned ldsw = (unsigned)wid * 1024u;
    const int aoff = lds_byte(wr * 64 + fr, fq * 8), boff = lds_byte(wc * 32 + fr, fq * 8);
#define PG8_SA(b, h) (((b) * 2 + (h)) * HTB)
#define PG8_SB(b, h) ((4 + (b) * 2 + (h)) * HTB)
#define PG8_STAGE(bufoff, gbase, voff) do { _Pragma("unroll") for (int _i = 0; _i < 2; ++_i) \
        __builtin_amdgcn_global_load_lds((const unsigned*)((const char*)(gbase) + (voff)[_i]), (PG8_LAS unsigned*)(lds + (bufoff) + ldsw + _i * 8192), 16, 0, 0); } while (0)
#define PG8_LDA(dst, b, h) do { _Pragma("unroll") for (int m = 0; m < 4; ++m) _Pragma("unroll") for (int k = 0; k < 2; ++k) dst[m][k] = *(const PG8_LAS bf16x8*)(lds + PG8_SA(b, h) + aoff + m * 2048 + k * 1024); } while (0)
#define PG8_LDB(dst, b, h) do { _Pragma("unroll") for (int n = 0; n < 2; ++n) _Pragma("unroll") for (int k = 0; k < 2; ++k) dst[n][k] = *(const PG8_LAS bf16x8*)(lds + PG8_SB(b, h) + boff + n * 2048 + k * 1024); } while (0)
#define PG8_MMA(ai, bj, At, Bt) do { __builtin_amdgcn_s_setprio(1); _Pragma("unroll") for (int m = 0; m < 4; ++m) _Pragma("unroll") for (int n = 0; n < 2; ++n) _Pragma("unroll") for (int k = 0; k < 2; ++k) \
        acc[ai][bj][m][n] = __builtin_amdgcn_mfma_f32_16x16x32_bf16(Bt[n][k], At[m][k], acc[ai][bj][m][n], 0, 0, 0); __builtin_amdgcn_s_setprio(0); } while (0)
#define PG8_WAIT_V(n) asm volatile("s_waitcnt vmcnt(" #n ")" ::: "memory")
#define PG8_WAIT_L(n) asm volatile("s_waitcnt lgkmcnt(" #n ")" ::: "memory")
#define PG8_BAR __builtin_amdgcn_s_barrier()
#define PG8_SCHED __builtin_amdgcn_sched_barrier(0)
    Unit cur, nxt; int ui = 0;
    if (!S.next(0, cur)) return;
    f32x4 acc[2][2][4][2];
#pragma unroll
    for (int a = 0; a < 2; ++a)
#pragma unroll
        for (int b = 0; b < 2; ++b)
#pragma unroll
            for (int m = 0; m < 4; ++m)
#pragma unroll
                for (int n = 0; n < 2; ++n) acc[a][b][m][n] = (f32x4){0.f, 0.f, 0.f, 0.f};
    bf16x8 At[4][2], B0[2][2], B1[2][2];
    const char* cA = (const char*)g.A + (size_t)cur.pm * tstep; const char* cB = (const char*)g.Bt + (size_t)cur.pn * tstep;
    S.a_ready(cur);
    if constexpr (SP2) {
        PG8_STAGE(PG8_SB(0, 0), cB, voffB); PG8_STAGE(PG8_SB(0, 1), cB + hstep, voffB); PG8_STAGE(PG8_SA(0, 0), cA, voffA); PG8_STAGE(PG8_SA(0, 1), cA + hstep, voffA);
        if (wr == 1) PG8_BAR;
        PG8_WAIT_V(2); PG8_BAR;
        PG8_STAGE(PG8_SB(1, 0), cB + kstep, voffB); PG8_STAGE(PG8_SA(1, 0), cA + kstep, voffA); PG8_STAGE(PG8_SB(1, 1), cB + hstep + kstep, voffB);
        PG8_WAIT_V(6); PG8_BAR;
    } else {
        PG8_STAGE(PG8_SB(0, 0), cB, voffB); PG8_STAGE(PG8_SA(0, 0), cA, voffA); PG8_STAGE(PG8_SB(0, 1), cB + hstep, voffB); PG8_STAGE(PG8_SA(0, 1), cA + hstep, voffA);
        if (wr == 1) PG8_BAR;
        PG8_WAIT_V(4); PG8_BAR;
        PG8_STAGE(PG8_SB(1, 0), cB + kstep, voffB); PG8_STAGE(PG8_SA(1, 0), cA + kstep, voffA); PG8_STAGE(PG8_SB(1, 1), cB + hstep + kstep, voffB);
        PG8_WAIT_V(6); PG8_BAR;
    }
    for (;;) {
        const bool has_next = S.next(ui + 1, nxt);
        const char* nA = has_next ? (const char*)g.A + (size_t)nxt.pm * tstep : cA; const char* nB = has_next ? (const char*)g.Bt + (size_t)nxt.pn * tstep : cB;
        for (int t = 0; t < nt; t += 2) {
            const bool last = (t == nt - 2);
            const char* a1 = cA + (size_t)(t + 1) * kstep;
            const char* a2 = last ? nA : cA + (size_t)(t + 2) * kstep; const char* b2 = last ? nB : cB + (size_t)(t + 2) * kstep;
            const char* a3 = a2 + kstep; const char* b3 = b2 + kstep;
            if (last && has_next) S.a_ready(nxt);
            if constexpr (SP2) {
            PG8_LDB(B0, 0, 0); PG8_LDB(B1, 0, 1); PG8_SCHED; PG8_LDA(At, 0, 0); PG8_STAGE(PG8_SA(1, 1), a1 + hstep, voffA);
            PG8_WAIT_V(8); PG8_WAIT_L(0); PG8_BAR; PG8_MMA(0, 0, At, B0); PG8_MMA(0, 1, At, B1); PG8_BAR; PG8_SCHED;
            PG8_LDA(At, 0, 1); PG8_STAGE(PG8_SB(0, 0), b2, voffB); PG8_STAGE(PG8_SB(0, 1), b2 + hstep, voffB); PG8_STAGE(PG8_SA(0, 0), a2, voffA);
            PG8_WAIT_V(8); PG8_WAIT_L(0); PG8_BAR; PG8_MMA(1, 0, At, B0); PG8_MMA(1, 1, At, B1); PG8_BAR; PG8_SCHED;
            PG8_LDB(B0, 1, 0); PG8_LDB(B1, 1, 1); PG8_SCHED; PG8_LDA(At, 1, 0); PG8_STAGE(PG8_SA(0, 1), a2 + hstep, voffA);
            PG8_WAIT_V(8); PG8_WAIT_L(0); PG8_BAR; PG8_MMA(0, 0, At, B0); PG8_MMA(0, 1, At, B1); PG8_BAR; PG8_SCHED;
            PG8_LDA(At, 1, 1); PG8_STAGE(PG8_SB(1, 0), b3, voffB); PG8_STAGE(PG8_SB(1, 1), b3 + hstep, voffB); PG8_STAGE(PG8_SA(1, 0), a3, voffA);
            PG8_WAIT_V(8); PG8_WAIT_L(0); PG8_BAR; PG8_MMA(1, 0, At, B0); PG8_MMA(1, 1, At, B1); PG8_BAR; PG8_SCHED;
            } else {
            PG8_LDB(B0, 0, 0); PG8_SCHED; PG8_LDA(At, 0, 0); PG8_STAGE(PG8_SA(1, 1), a1 + hstep, voffA);
            PG8_WAIT_L(8); PG8_BAR; PG8_WAIT_L(0); PG8_MMA(0, 0, At, B0); PG8_BAR; PG8_SCHED;
            PG8_LDB(B1, 0, 1); PG8_STAGE(PG8_SB(0, 0), b2, voffB);
            PG8_BAR; PG8_WAIT_L(0); PG8_MMA(0, 1, At, B1); PG8_BAR;
            PG8_LDA(At, 0, 1); PG8_STAGE(PG8_SA(0, 0), a2, voffA);
            PG8_BAR; PG8_WAIT_L(0); PG8_MMA(1, 0, At, B0); PG8_BAR; PG8_SCHED;
            PG8_STAGE(PG8_SB(0, 1), b2 + hstep, voffB);
            PG8_WAIT_V(6); PG8_BAR; PG8_MMA(1, 1, At, B1); PG8_BAR;
            PG8_LDB(B0, 1, 0); PG8_SCHED; PG8_LDA(At, 1, 0); PG8_STAGE(PG8_SA(0, 1), a2 + hstep, voffA);
            PG8_WAIT_L(8); PG8_BAR; PG8_WAIT_L(0); PG8_MMA(0, 0, At, B0); PG8_BAR; PG8_SCHED;
            PG8_LDB(B1, 1, 1); PG8_STAGE(PG8_SB(1, 0), b3, voffB);
            PG8_BAR; PG8_WAIT_L(0); PG8_MMA(0, 1, At, B1); PG8_BAR;
            PG8_LDA(At, 1, 1); PG8_STAGE(PG8_SA(1, 0), a3, voffA);
            PG8_BAR; PG8_WAIT_L(0); PG8_MMA(1, 0, At, B0); PG8_BAR; PG8_SCHED;
            PG8_STAGE(PG8_SB(1, 1), b3 + hstep, voffB);
            PG8_WAIT_V(6); PG8_BAR; PG8_MMA(1, 1, At, B1); PG8_BAR;
            }
        }
        if constexpr (ALIGN_EPI) { if (wr == 0) PG8_BAR; }
        if constexpr (!Epi::AFTER_DRAIN) { E(acc, cur, wr, wc, fr, fq); S.done(cur); }
        if (!has_next) break;
#pragma unroll
        for (int a = 0; a < 2; ++a)
#pragma unroll
            for (int b = 0; b < 2; ++b)
#pragma unroll
                for (int m = 0; m < 4; ++m)
#pragma unroll
                    for (int n = 0; n < 2; ++n) acc[a][b][m][n] = (f32x4){0.f, 0.f, 0.f, 0.f};
        cur = nxt; cA = nA; cB = nB; ++ui;
        if constexpr (ALIGN_EPI) { if (wr == 1) PG8_BAR; }
    }
    PG8_WAIT_V(0);
    if constexpr (!ALIGN_EPI) { if (wr == 0) PG8_BAR; }
    PG8_BAR;
    if constexpr (Epi::AFTER_DRAIN) { E.fused(acc, cur, wr, wc, fr, fq, lds, wid, lane); S.done(cur); }
#undef PG8_SA
#undef PG8_SB
#undef PG8_STAGE
#undef PG8_LDA
#undef PG8_LDB
#undef PG8_MMA
#undef PG8_WAIT_V
#undef PG8_WAIT_L
#undef PG8_BAR
#undef PG8_SCHED
}
}
#define LAS __attribute__((address_space(3)))
typedef unsigned short bf16;
typedef unsigned u32x4 __attribute__((ext_vector_type(4)));
typedef unsigned u32x2 __attribute__((ext_vector_type(2)));
typedef float f32x4 __attribute__((ext_vector_type(4)));
typedef float f32x16 __attribute__((ext_vector_type(16)));
typedef short bf16x8 __attribute__((ext_vector_type(8)));
typedef short s16x4 __attribute__((ext_vector_type(4)));

constexpr int DM = 1024, NB = 8, SEQ = 4096, CTXL = 256, NL = NB * SEQ, NC = NB * CTXL, MT = NL + NC, DFF = 2816, NMOD = 9 * DM;
constexpr float EPS = 1e-6f;
constexpr float LOG2E = 1.4426950408889634f;
constexpr int NTHREADS = 512;
constexpr int LDS_BYTES = 131072 + 1024;

struct Params {
    const float *x, *c, *ctx, *c_ctx, *ada_w, *ada_b, *norm_g, *ffn_w_in, *ffn_w_out;
    const float *da_w_in, *da_lambda, *da_subln, *da_w_out;
    const float *ga_w_in, *ga_q_norm, *ga_k_norm, *ga_w_out;
    const float *mla_w_in, *mla_q_norm, *mla_kv_norm, *mla_w_uq, *mla_w_ukv, *mla_w_out;
    const float *swa_w_in, *swa_sink, *swa_w_out;
    float* out; unsigned char* ws;
};

constexpr size_t MiB = (size_t)1 << 20;
constexpr size_t WS_BAR = MiB + MiB / 2;
constexpr size_t WS_MOD = 0, WS_PART = 2 * MiB, WS_HC = 24 * MiB;
constexpr size_t WS_FIN = 32 * MiB, FIN_BYTES = 11 * MiB;
constexpr size_t WS_FOUT = 120 * MiB, FOUT_BYTES = 5 * MiB + MiB / 2;
constexpr size_t WS_DA_IN = 164 * MiB, WS_DA_OUT = 170 * MiB, WS_GA_IN = 172 * MiB, WS_GA_OUT = 175 * MiB;
constexpr size_t WS_MLA_IN = 177 * MiB, WS_MLA_UQ = 178 * MiB, WS_MLA_UKV = 179 * MiB, WS_MLA_OUT = 180 * MiB;
constexpr size_t WS_SWA_IN = 182 * MiB, WS_SWA_OUT = 185 * MiB;
constexpr size_t WS_A = 188 * MiB;
constexpr size_t WS_Y = 256 * MiB;
constexpr size_t WS_U = 392 * MiB;
constexpr size_t WS_END = 640 * MiB;
constexpr size_t WS_CIN = WS_Y, WS_AQ = WS_Y + 34 * MiB, WS_AKV = WS_Y + 51 * MiB, WS_MQ = WS_U, WS_MKV = WS_U + 102 * MiB;
constexpr int NKC = 16;

__device__ __forceinline__ float wave_sum(float v) {
#pragma unroll
    for (int o = 1; o < 64; o <<= 1) v += __shfl_xor(v, o);
    return v;
}
__device__ __forceinline__ unsigned pk2(float lo, float hi) { return pg8::cvt_pk_bf16(lo, hi); }
__device__ __forceinline__ float bflo(unsigned w) { return __uint_as_float(w << 16); }
__device__ __forceinline__ float bfhi(unsigned w) { return __uint_as_float(w & 0xffff0000u); }
__device__ __forceinline__ float silu_f(float v) { return v / (1.0f + __expf(-v)); }

__device__ __forceinline__ void transpose_item(const float* __restrict__ W, int N, bf16* WT, int ldk, int k0, int n0, int drow0, LAS float* scr, int lane) {
#pragma unroll 8
    for (int i = 0; i < 32; ++i) { const int kk = 2 * i + (lane >> 5); scr[kk * 33 + (lane & 31)] = W[(size_t)(k0 + kk) * N + n0 + (lane & 31)]; }
    asm volatile("s_waitcnt lgkmcnt(0)" ::: "memory");
    const int c = lane & 7;
#pragma unroll
    for (int j = 0; j < 4; ++j) { const int n = (lane >> 3) + 8 * j; const LAS float* s = scr + (8 * c) * 33 + n;
        u32x4 o; o.x = pk2(s[0 * 33], s[1 * 33]); o.y = pk2(s[2 * 33], s[3 * 33]); o.z = pk2(s[4 * 33], s[5 * 33]); o.w = pk2(s[6 * 33], s[7 * 33]);
        *(u32x4*)(WT + (size_t)(drow0 + n) * ldk + k0 + 8 * c) = o; }
    asm volatile("s_waitcnt lgkmcnt(0)" ::: "memory");
}
__device__ __forceinline__ int swiglu_row(int n0) { return n0 < DFF ? (n0 >> 7) * 256 + (n0 & 127) : ((n0 - DFF) >> 7) * 256 + 128 + ((n0 - DFF) & 127); }

__device__ __forceinline__ void phase0(const Params& p, LAS unsigned char* lds, int G) {
    const int tid = tid_opaque(), lane = tid & 63, wid = tid >> 6;
    unsigned char* ws = p.ws;
    LAS float* sc = (LAS float*)lds;
    for (int i = tid; i < 9 * DM; i += NTHREADS) { const float v = i < 8 * DM ? p.c[i] : p.c_ctx[i - 8 * DM]; sc[i] = silu_f(v); }
    __syncthreads();
    {
        const int gt = bid_opaque() * NTHREADS + tid, GT = G * NTHREADS;
        float* part = (float*)(ws + WS_PART);
        for (int w = gt; w < 4 * NKC * (NMOD / 4); w += GT) {
            const int col4 = w % (NMOD / 4), kc = (w / (NMOD / 4)) % NKC, layer = w / ((NMOD / 4) * NKC);
            const float* wp = p.ada_w + ((size_t)layer * DM + kc * 64) * NMOD + col4 * 4;
            f32x4 acc[9];
#pragma unroll
            for (int r = 0; r < 9; ++r) acc[r] = (f32x4){0.f, 0.f, 0.f, 0.f};
#pragma unroll 4
            for (int k = 0; k < 64; ++k) {
                const f32x4 wv = *(const f32x4*)(wp + (size_t)k * NMOD);
#pragma unroll
                for (int r = 0; r < 9; ++r) { const float s = sc[r * DM + kc * 64 + k]; acc[r] += wv * s; }
            }
#pragma unroll
            for (int r = 0; r < 9; ++r) *(f32x4*)(part + ((size_t)(kc * 4 + layer) * 9 + r) * NMOD + col4 * 4) = acc[r];
        }
    }
    {
        LAS float* scr = (LAS float*)(lds + 40960) + wid * (64 * 33);
        const int gw = bid_opaque() * 8 + wid, NGW = G * 8;
        constexpr int I_FIN = 16 * 176, I_FOUT = 44 * 32, I_SQ = 16 * 32;
        constexpr int I_DA_IN = 16 * 96, I_GA_IN = 16 * 48, I_MLA_IN = 16 * 13, I_MLA_UQ = 4 * 48, I_MLA_UKV = 2 * 64, I_SWA_IN = 16 * 40;
        constexpr int TOTAL = 8 * I_FIN + 8 * I_FOUT + 4 * I_SQ + I_DA_IN + I_GA_IN + I_MLA_IN + I_MLA_UQ + I_MLA_UKV + I_SWA_IN;
        for (int it = gw; it < TOTAL; it += NGW) {
            int r = it;
            if (r < 8 * I_FIN) { const int f = r / I_FIN, rr = r % I_FIN, kb = rr / 176, n0 = (rr % 176) * 32;
                transpose_item(p.ffn_w_in + (size_t)f * DM * 2 * DFF, 2 * DFF, (bf16*)(ws + WS_FIN + f * FIN_BYTES), DM, kb * 64, n0, swiglu_row(n0), scr, lane); continue; }
            r -= 8 * I_FIN;
            if (r < 8 * I_FOUT) { const int f = r / I_FOUT, rr = r % I_FOUT, kb = rr / 32, n0 = (rr % 32) * 32;
                transpose_item(p.ffn_w_out + (size_t)f * DFF * DM, DM, (bf16*)(ws + WS_FOUT + f * FOUT_BYTES), DFF, kb * 64, n0, n0, scr, lane); continue; }
            r -= 8 * I_FOUT;
#define MATX(SRC, K_, N_, DST, LDK) { constexpr int nit_ = ((K_) / 64) * ((N_) / 32); if (r < nit_) { const int kb = r / ((N_) / 32), n0 = (r % ((N_) / 32)) * 32; \
                transpose_item(SRC, N_, (bf16*)(ws + (DST)), LDK, kb * 64, n0, n0, scr, lane); continue; } r -= nit_; }
            MATX(p.da_w_out, 1024, 1024, WS_DA_OUT, 1024)
            MATX(p.ga_w_out, 1024, 1024, WS_GA_OUT, 1024)
            MATX(p.mla_w_out, 1024, 1024, WS_MLA_OUT, 1024)
            MATX(p.swa_w_out, 1024, 1024, WS_SWA_OUT, 1024)
            MATX(p.da_w_in, 1024, 3072, WS_DA_IN, 1024)
            MATX(p.ga_w_in, 1024, 1536, WS_GA_IN, 1024)
            MATX(p.mla_w_in, 1024, 416, WS_MLA_IN, 1024)
            MATX(p.mla_w_uq, 256, 1536, WS_MLA_UQ, 256)
            MATX(p.mla_w_ukv, 128, 2048, WS_MLA_UKV, 128)
            MATX(p.swa_w_in, 1024, 1280, WS_SWA_IN, 1024)
#undef MATX
        }
        const int gt = bid_opaque() * NTHREADS + tid, GT = G * NTHREADS;
        for (int i = gt; i < 96 * 1024 / 8; i += GT) *(u32x4*)((bf16*)(ws + WS_MLA_IN) + (size_t)416 * 1024 + (size_t)i * 8) = (u32x4){0u, 0u, 0u, 0u};
    }
}
__device__ __forceinline__ void phase0b(const Params& p, int G) {
    const int gt = bid_opaque() * NTHREADS + tid_opaque(), GT = G * NTHREADS;
    const float* part = (const float*)(p.ws + WS_PART); float* mod = (float*)(p.ws + WS_MOD);
    for (int o = gt; o < 4 * 9 * NMOD / 4; o += GT) {
        const int col4 = o % (NMOD / 4), lr = o / (NMOD / 4), layer = lr / 9;
        f32x4 a = *(const f32x4*)(p.ada_b + (size_t)layer * NMOD + col4 * 4);
#pragma unroll
        for (int kc = 0; kc < NKC; ++kc) a += *(const f32x4*)(part + ((size_t)(kc * 4 + layer) * 9 + (lr % 9)) * NMOD + col4 * 4);
        *(f32x4*)(mod + (size_t)lr * NMOD + col4 * 4) = a;
    }
}

template <bool INIT, bool RES, bool NEXT>
__device__ __forceinline__ void rowop_rows(const Params& p, int row0, int nrows, int gw, int NGW, float wgt, const float* mod_res, int kgate, const float* g_post,
                                           const float* mod_next, int knext, const float* g_pre) {
    const int lane = tid_opaque() & 63;
    float* hc = (float*)(p.ws + WS_HC); const bf16* Y = (const bf16*)(p.ws + WS_Y); bf16* A = (bf16*)(p.ws + WS_A);
    for (int ri = gw; ri < nrows; ri += NGW) {
        const int row = row0 + ri;
        const bool lat = row < NL;
        const int mr = lat ? (row >> 12) : 8;
        float* hrow = lat ? p.out + (size_t)row * DM : hc + (size_t)(row - NL) * DM;
        f32x4 h[4];
        if (INIT) { const float* xr = lat ? p.x + (size_t)row * DM : p.ctx + (size_t)(row - NL) * DM;
#pragma unroll
            for (int j = 0; j < 4; ++j) h[j] = *(const f32x4*)(xr + 256 * j + 4 * lane); }
        else if (lat) {
#pragma unroll
            for (int j = 0; j < 4; ++j) { const u32x2 hw = *(const u32x2*)((const bf16*)hrow + 256 * j + 4 * lane); h[j] = (f32x4){bflo(hw.x), bfhi(hw.x), bflo(hw.y), bfhi(hw.y)}; } }
        else {
#pragma unroll
            for (int j = 0; j < 4; ++j) h[j] = *(const f32x4*)(hrow + 256 * j + 4 * lane); }
        if (RES) {
            f32x4 y[4]; float ss = 0.f;
#pragma unroll
            for (int j = 0; j < 4; ++j) { const u32x2 yw = *(const u32x2*)(Y + (size_t)row * DM + 256 * j + 4 * lane); y[j] = (f32x4){bflo(yw.x), bfhi(yw.x), bflo(yw.y), bfhi(yw.y)}; ss += (y[j].x * y[j].x + y[j].y * y[j].y) + (y[j].z * y[j].z + y[j].w * y[j].w); }
            const float r = wgt * __builtin_amdgcn_rsqf(wave_sum(ss) * (1.0f / DM) + EPS);
            const float* gate = mod_res + (size_t)mr * NMOD + kgate * DM;
#pragma unroll
            for (int j = 0; j < 4; ++j) { const f32x4 gt_ = *(const f32x4*)(gate + 256 * j + 4 * lane), gp = *(const f32x4*)(g_post + 256 * j + 4 * lane); h[j] += gt_ * (y[j] * r) * gp; }
        }
        if (INIT || RES) {
            if (lat && NEXT) {
#pragma unroll
                for (int j = 0; j < 4; ++j) { u32x2 w; w.x = pk2(h[j].x, h[j].y); w.y = pk2(h[j].z, h[j].w); *(u32x2*)((bf16*)hrow + 256 * j + 4 * lane) = w; } }
            else {
#pragma unroll
                for (int j = 0; j < 4; ++j) *(f32x4*)(hrow + 256 * j + 4 * lane) = h[j]; } }
        if (NEXT) {
            float ss = 0.f;
#pragma unroll
            for (int j = 0; j < 4; ++j) ss += (h[j].x * h[j].x + h[j].y * h[j].y) + (h[j].z * h[j].z + h[j].w * h[j].w);
            const float r = __builtin_amdgcn_rsqf(wave_sum(ss) * (1.0f / DM) + EPS);
            const float* shift = mod_next + (size_t)mr * NMOD + knext * DM; const float* scale = shift + DM;
#pragma unroll
            for (int j = 0; j < 4; ++j) { const f32x4 sh = *(const f32x4*)(shift + 256 * j + 4 * lane), scl = *(const f32x4*)(scale + 256 * j + 4 * lane), gp = *(const f32x4*)(g_pre + 256 * j + 4 * lane);
                const f32x4 a = (h[j] * r) * gp * (scl + 1.0f) + sh;
                u32x2 w; w.x = pk2(a.x, a.y); w.y = pk2(a.z, a.w); *(u32x2*)(A + (size_t)row * DM + 256 * j + 4 * lane) = w; }
        }
    }
}

template <bool INIT, bool RES, bool NEXT>
__device__ __forceinline__ void rowop(const Params& p, int G, int nrows, float wgt, const float* mod_res, int kgate, const float* g_post,
                                      const float* mod_next, int knext, const float* g_pre) {
    rowop_rows<INIT, RES, NEXT>(p, 0, nrows, bid_opaque() * 8 + (tid_opaque() >> 6), G * 8, wgt, mod_res, kgate, g_post, mod_next, knext, g_pre);
}

template <int NAX> __device__ __forceinline__ void rope_cs(int j, int s, float& cs, float& sn) {
    const int f = j % NAX; const float pos = (float)(j < NAX ? (s >> 6) : (s & 63));
    const float freq = __builtin_amdgcn_exp2f(-13.287712379549449f * (float)f / (float)NAX);
    const float ang = pos * freq; cs = __cosf(ang); sn = __sinf(ang);
}
__device__ __forceinline__ unsigned rope_pair(unsigned w, float cs, float sn) { const float x0 = bflo(w), x1 = bfhi(w); return pk2(x0 * cs - x1 * sn, x0 * sn + x1 * cs); }

__device__ __forceinline__ void post_da(const Params& p, int G) {
    const int lane = tid_opaque() & 63, wid = tid_opaque() >> 6, gw = bid_opaque() * 8 + wid, NGW = G * 8;
    bf16* Q = (bf16*)(p.ws + WS_U);
    for (int row = gw; row < NL; row += NGW) {
        float cs, sn; rope_cs<16>(lane & 31, row & 4095, cs, sn);
        unsigned* rp = (unsigned*)(Q + (size_t)row * 3072) + (lane >> 5) * 32 + (lane & 31);
#pragma unroll 4
        for (int it = 0; it < 16; ++it) rp[it * 64] = rope_pair(rp[it * 64], cs, sn);
    }
}
__device__ __forceinline__ void post_swa(const Params& p, int G) {
    const int lane = tid_opaque() & 63, wid = tid_opaque() >> 6, gw = bid_opaque() * 8 + wid, NGW = G * 8;
    bf16* Q = (bf16*)(p.ws + WS_U);
    for (int row = gw; row < NL; row += NGW) {
        float cs, sn; rope_cs<16>(lane & 31, row & 4095, cs, sn);
        unsigned* rp = (unsigned*)(Q + (size_t)row * 1280) + (lane >> 5) * 32 + (lane & 31);
#pragma unroll 3
        for (int it = 0; it < 9; ++it) rp[it * 64] = rope_pair(rp[it * 64], cs, sn);
    }
}
__device__ __forceinline__ void post_ga(const Params& p, int G) {
    const int lane = tid_opaque() & 63, wid = tid_opaque() >> 6, gw = bid_opaque() * 8 + wid, NGW = G * 8;
    bf16* Q = (bf16*)(p.ws + WS_U);
    const float gq0 = p.ga_q_norm[2 * lane], gq1 = p.ga_q_norm[2 * lane + 1], gk0 = p.ga_k_norm[2 * lane], gk1 = p.ga_k_norm[2 * lane + 1];
    for (int row = gw; row < MT; row += NGW) {
        float cs = 1.f, sn = 0.f; if (row < NL) rope_cs<32>(lane, row & 4095, cs, sn);
        unsigned* rp = (unsigned*)(Q + (size_t)row * 1536) + lane;
#pragma unroll
        for (int s = 8; s < 10; ++s) { const unsigned w = rp[s * 64]; float x0 = bflo(w), x1 = bfhi(w);
            const float r = __builtin_amdgcn_rsqf(wave_sum(x0 * x0 + x1 * x1) * (1.0f / 128.0f) + EPS);
            x0 = x0 * r * (s < 8 ? gq0 : gk0); x1 = x1 * r * (s < 8 ? gq1 : gk1);
            rp[s * 64] = pk2(x0 * cs - x1 * sn, x0 * sn + x1 * cs); }
    }
}
__device__ __forceinline__ void post_mla1(const Params& p, int G) {
    const int lane = tid_opaque() & 63, wid = tid_opaque() >> 6, gw = bid_opaque() * 8 + wid, NGW = G * 8;
    bf16* CIN = (bf16*)(p.ws + WS_CIN); bf16* AQ = (bf16*)(p.ws + WS_AQ); bf16* AKV = (bf16*)(p.ws + WS_AKV);
    const f32x4 gq = *(const f32x4*)(p.mla_q_norm + 4 * lane); const float gk0 = p.mla_kv_norm[2 * lane], gk1 = p.mla_kv_norm[2 * lane + 1];
    for (int row = gw; row < MT; row += NGW) {
        const bf16* cr = CIN + (size_t)row * 512;
        const u32x2 wq = *(const u32x2*)(cr + 4 * lane); const unsigned wk = *(const unsigned*)(cr + 256 + 2 * lane);
        const float q0 = bflo(wq.x), q1 = bfhi(wq.x), q2 = bflo(wq.y), q3 = bfhi(wq.y), k0 = bflo(wk), k1 = bfhi(wk);
        const float rq = __builtin_amdgcn_rsqf(wave_sum((q0 * q0 + q1 * q1) + (q2 * q2 + q3 * q3)) * (1.0f / 256.0f) + EPS);
        const float rk = __builtin_amdgcn_rsqf(wave_sum(k0 * k0 + k1 * k1) * (1.0f / 128.0f) + EPS);
        u32x2 oq; oq.x = pk2(q0 * rq * gq.x, q1 * rq * gq.y); oq.y = pk2(q2 * rq * gq.z, q3 * rq * gq.w);
        *(u32x2*)(AQ + (size_t)row * 256 + 4 * lane) = oq;
        *(unsigned*)(AKV + (size_t)row * 128 + 2 * lane) = pk2(k0 * rk * gk0, k1 * rk * gk1);
        if (row < NL && lane < 16) { float cs, sn; rope_cs<8>(lane, row & 4095, cs, sn);
            unsigned* kp = (unsigned*)(CIN + (size_t)row * 512 + 384) + lane; *kp = rope_pair(*kp, cs, sn); }
    }
}
__device__ __forceinline__ void post_mla2(const Params& p, int G) {
    const int lane = tid_opaque() & 63, wid = tid_opaque() >> 6, gw = bid_opaque() * 8 + wid, NGW = G * 8;
    bf16* Q = (bf16*)(p.ws + WS_MQ);
    for (int row = gw; row < NL; row += NGW) {
        float cs, sn; rope_cs<8>(lane & 15, row & 4095, cs, sn);
#pragma unroll
        for (int it = 0; it < 4; ++it) { const int head = it * 4 + (lane >> 4);
            unsigned* qp = (unsigned*)(Q + (size_t)row * 1536 + head * 96 + 64) + (lane & 15); *qp = rope_pair(*qp, cs, sn); }
    }
}
__device__ __forceinline__ void da_combine(const Params& p, int G, float lambda_init) {
    const int lane = tid_opaque() & 63, wid = tid_opaque() >> 6, gw = bid_opaque() * 8 + wid, NGW = G * 8;
    const bf16* T = (const bf16*)(p.ws + WS_Y); bf16* O = (bf16*)(p.ws + WS_A);
    const float* lm = p.da_lambda;
    const float lam = __expf(wave_sum(lm[lane] * lm[64 + lane])) - __expf(wave_sum(lm[128 + lane] * lm[192 + lane])) + lambda_init;
    const int h = lane >> 3, d0 = (lane & 7) * 16;
    float g[16];
#pragma unroll
    for (int e = 0; e < 16; ++e) g[e] = p.da_subln[d0 + e] * (1.0f - lambda_init);
    for (int row = gw; row < MT; row += NGW) {
        const bf16* t1 = T + (size_t)row * 2048 + h * 256 + d0; const bf16* t2 = t1 + 128;
        const u32x4 a0 = *(const u32x4*)t1, a1 = *(const u32x4*)(t1 + 8), b0 = *(const u32x4*)t2, b1 = *(const u32x4*)(t2 + 8);
        float o[16];
#pragma unroll
        for (int e = 0; e < 4; ++e) { o[2 * e] = bflo(a0[e]) - lam * bflo(b0[e]); o[2 * e + 1] = bfhi(a0[e]) - lam * bfhi(b0[e]);
                                      o[8 + 2 * e] = bflo(a1[e]) - lam * bflo(b1[e]); o[8 + 2 * e + 1] = bfhi(a1[e]) - lam * bfhi(b1[e]); }
        float ss = 0.f;
#pragma unroll
        for (int e = 0; e < 16; ++e) ss += o[e] * o[e];
        ss += __shfl_xor(ss, 1); ss += __shfl_xor(ss, 2); ss += __shfl_xor(ss, 4);
        const float r = __builtin_amdgcn_rsqf(ss * (1.0f / 128.0f) + EPS);
        u32x4 w0, w1;
#pragma unroll
        for (int e = 0; e < 4; ++e) { w0[e] = pk2(o[2 * e] * r * g[2 * e], o[2 * e + 1] * r * g[2 * e + 1]); w1[e] = pk2(o[8 + 2 * e] * r * g[8 + 2 * e], o[8 + 2 * e + 1] * r * g[8 + 2 * e + 1]); }
        bf16* op = O + (size_t)row * DM + h * 128 + d0; *(u32x4*)op = w0; *(u32x4*)(op + 8) = w1;
    }
}

struct AttnDesc {
    const bf16 *Q, *K, *K2, *V; bf16* O; int ldq, ldk, ldk2, ldv, ldo;
    int nh, q_mul, k_off, k_div, k_mul, k2_off, v_off, v_div, v_mul, o_mul; float scale; const float* sink;
    bf16* O2; const float* aux; const float* lam; float lam_init;
};
__device__ __forceinline__ s16x4 vtr(const LAS unsigned char* ptr) { return __builtin_bit_cast(s16x4, __builtin_amdgcn_ds_read_tr16_b64_v4i16((LAS s16x4*)ptr)); }
typedef __bf16 bf16x2_t __attribute__((ext_vector_type(2))); typedef float f32x2_t __attribute__((ext_vector_type(2)));
__device__ __forceinline__ unsigned cvtpk(float lo, float hi) { f32x2_t v = {lo, hi}; bf16x2_t b = __builtin_convertvector(v, bf16x2_t); return __builtin_bit_cast(unsigned, b); }

__device__ __forceinline__ float swapmax(float v) { auto rr = __builtin_amdgcn_permlane32_swap(__float_as_uint(v), __float_as_uint(v), false, false); return fmaxf(__uint_as_float(rr[0]), __uint_as_float(rr[1])); }
__device__ __forceinline__ float swapsum(float v) { auto rr = __builtin_amdgcn_permlane32_swap(__float_as_uint(v), __float_as_uint(v), false, false); return __uint_as_float(rr[0]) + __uint_as_float(rr[1]); }
#define SBAR() __builtin_amdgcn_sched_barrier(0)
#ifndef ATT_DSMASK
#define ATT_DSMASK 0x00F
#endif
#define ATT_DSFENCE() __builtin_amdgcn_sched_barrier(ATT_DSMASK)
template <int DQK, int DK1, int DV, bool SWA, bool DIFF = false>
__device__ __forceinline__ void attn_phase(LAS unsigned char* lds, const AttnDesc d, bool with_ctx, int G) {
    constexpr int KP = DQK * 2 + 16, VP = (DV == 128) ? 320 : 192, KBUF = 64 * KP, VBUF = 64 * VP, BUFB = KBUF + VBUF;
    constexpr int NS = DQK / 16, ND = DV / 32, KCH = DQK / 8, VCH = DV / 8, NKCH = 64 * KCH, NVCH = 64 * VCH, KI = (NKCH + 511) / 512, VI = (NVCH + 511) / 512;
    static_assert(3 * BUFB <= 131072, "attention ring fits the LDS region");
    constexpr bool SD2 = !(DQK == 128 && DV == 128) && !DIFF;
#ifndef ATT_SGB
#define ATT_SGB true
#endif
    constexpr bool SGB = ATT_SGB; constexpr int SGB_TQ = (16 + 2 * NS - 1) / (2 * NS), SGB_VQ = (48 + 2 * NS - 1) / (2 * NS), SGB_VP = (52 + 4 * ND - 1) / (4 * ND);
    constexpr bool QPREP = (DQK == 128 && DV == 128);
    constexpr bool SEQF = (DQK == 128 && DV == 128);
    const int tid = tid_opaque(), lane = tid & 63, wid = __builtin_amdgcn_readfirstlane(tid >> 6), r32 = lane & 31, hi = lane >> 5;
    const float C = d.scale * LOG2E; constexpr float THRS = 8.0f * LOG2E;
    const int n_lat = NB * d.nh * 16, n_units = n_lat + (with_ctx ? NB * d.nh : 0);
    const int bid_ = bid_opaque(), vcu = (G % 8 == 0) ? (bid_ % 8) * (G / 8) + bid_ / 8 : bid_;
    for (int u = vcu; u < n_units; u += G) {
        int b, head, qb; bool isctx;
        if (u < n_lat) { qb = u & 15; head = (u >> 4) % d.nh; b = (u >> 4) / d.nh; isctx = false; }
        else { const int v = u - n_lat; head = v % d.nh; b = v / d.nh; qb = 0; isctx = true; }
        for (int sub = 0; sub < (DIFF ? 2 : 1); ++sub) {
        const int he = DIFF ? head * 2 + sub : head;
        const int qrow_base = (isctx ? NL + b * CTXL : b * SEQ + qb * 256) + wid * 32;
        const int kcol = d.k_off + (he / d.k_div) * d.k_mul, vcol = d.v_off + (he / d.v_div) * d.v_mul;
        int lat_lo = 0, nlt = isctx ? 0 : 64;
        if (SWA) { const int q0 = qb * 256; lat_lo = q0 - 128 < 0 ? 0 : q0 - 128; const int lat_hi = q0 + 384 > SEQ ? SEQ : q0 + 384; nlt = (lat_hi - lat_lo) >> 6; }
        const int NT = 4 + nlt;
        const int ctx_row0 = NL + b * CTXL, lat_row0 = b * SEQ + lat_lo;
        const int qpos = qb * 256 + wid * 32 + r32;
        bf16x8 qf[NS];
        { int lq_ = lane; asm volatile("" : "+v"(lq_)); const bf16* qp = d.Q + (size_t)(qrow_base + (lq_ & 31)) * d.ldq + he * d.q_mul + (lq_ >> 5) * 8;
#pragma unroll
          for (int s = 0; s < NS; ++s) qf[s] = *(const bf16x8*)(qp + s * 16); }
        if (QPREP) {
            float ssq = 0.f;
#pragma unroll
            for (int s = 0; s < NS; ++s)
#pragma unroll
                for (int e = 0; e < 8; ++e) { const float v = __uint_as_float((unsigned)(unsigned short)qf[s][e] << 16); ssq += v * v; }
            ssq = swapsum(ssq);
            const float rq = __builtin_amdgcn_rsqf(ssq * (1.0f / 128.0f) + EPS);
            int lh_ = lane; asm volatile("" : "+v"(lh_)); const int hq = lh_ >> 5, rq32 = lh_ & 31;
            const int sp_ = (qrow_base + rq32) & 4095; const float prow = (float)(sp_ >> 6), pcol = (float)(sp_ & 63);
#pragma unroll
            for (int s = 0; s < NS; ++s) {
                const f32x4 g0 = *(const f32x4*)(d.aux + s * 16 + hq * 8), g1 = *(const f32x4*)(d.aux + s * 16 + hq * 8 + 4);
                float x[8];
#pragma unroll
                for (int e = 0; e < 8; ++e) x[e] = __uint_as_float((unsigned)(unsigned short)qf[s][e] << 16) * rq * (e < 4 ? g0[e] : g1[e - 4]);
                if (!isctx) {
#pragma unroll
                    for (int pr = 0; pr < 4; ++pr) { const int j = s * 8 + hq * 4 + pr;
                        const float freq = __builtin_amdgcn_exp2f(-13.287712379549449f * (float)(j & 31) * (1.0f / 32.0f)); const float ang = (s < 4 ? prow : pcol) * freq;
                        const float cs = __cosf(ang), sn = __sinf(ang), a = x[2 * pr], b2 = x[2 * pr + 1]; x[2 * pr] = a * cs - b2 * sn; x[2 * pr + 1] = a * sn + b2 * cs; } }
                u32x4 w; w.x = cvtpk(x[0], x[1]); w.y = cvtpk(x[2], x[3]); w.z = cvtpk(x[4], x[5]); w.w = cvtpk(x[6], x[7]); qf[s] = __builtin_bit_cast(bf16x8, w);
            }
        }
        u32x4 kreg0[KI], vreg0[VI], kreg1[KI], vreg1[VI];
    constexpr bool K2S = (DK1 != DQK); constexpr int KCHA = K2S ? DK1 / 8 : KCH, KCHB = K2S ? (DQK - DK1) / 8 : 1, KRP = 512 / KCHA, VRP = 512 / VCH;
    static_assert(512 % KCHA == 0 && 512 % VCH == 0 && (!K2S || (64 * KCHA == 512 && 64 * KCHB <= 512 && KI == 2)), "staging map");
    constexpr bool HOIST = true;
    unsigned h_vgo = 0, h_kgo = 0, h_kgoB = 0, h_vlo = 0, h_klo = 0, h_kloB = 0;
    if (HOIST) { h_vgo = (unsigned)((tid / VCH) * d.ldv + (tid % VCH) * 8) * 2u; h_kgo = (unsigned)((tid / KCHA) * d.ldk + (tid % KCHA) * 8) * 2u; h_kgoB = K2S ? (unsigned)((tid / KCHB) * d.ldk2 + (tid % KCHB) * 8) * 2u : 0u;
        h_vlo = (unsigned)((tid / VCH) * VP + (tid % VCH) * 16); h_klo = (unsigned)((tid / KCHA) * KP + (tid % KCHA) * 16); h_kloB = K2S ? (unsigned)((tid / KCHB) * KP + DK1 * 2 + (tid % KCHB) * 16) : 0u; }
#define ATT_GOFF() unsigned vgo, kgo, kgoB; if (HOIST) { vgo = h_vgo; kgo = h_kgo; kgoB = h_kgoB; } else { int t2_ = tid; asm volatile("" : "+v"(t2_)); \
            vgo = (unsigned)((t2_ / VCH) * d.ldv + (t2_ % VCH) * 8) * 2u; kgo = (unsigned)((t2_ / KCHA) * d.ldk + (t2_ % KCHA) * 8) * 2u; kgoB = K2S ? (unsigned)((t2_ / KCHB) * d.ldk2 + (t2_ % KCHB) * 8) * 2u : 0u; } (void)kgoB
#define ATT_LOFF() unsigned vlo, klo, kloB; if (HOIST) { vlo = h_vlo; klo = h_klo; kloB = h_kloB; } else { int t3_ = tid; asm volatile("" : "+v"(t3_)); \
            vlo = (unsigned)((t3_ / VCH) * VP + (t3_ % VCH) * 16); klo = (unsigned)((t3_ / KCHA) * KP + (t3_ % KCHA) * 16); kloB = K2S ? (unsigned)((t3_ / KCHB) * KP + DK1 * 2 + (t3_ % KCHB) * 16) : 0u; } (void)kloB
#define ATT_LOAD(t_, kreg, vreg) ATT_LOADX(t_, kreg, vreg, ctx_row0, lat_row0, kcol, vcol)
#define ATT_LOADX(t_, kreg, vreg, ctx_row0, lat_row0, kcol, vcol) do { ATT_GOFF(); const int krow0_ = (t_) < 4 ? ctx_row0 + (t_) * 64 : lat_row0 + ((t_) - 4) * 64; \
            if (!K2S) { _Pragma("unroll") for (int i_ = 0; i_ < KI; ++i_) { const char* kb_ = (const char*)(d.K + (size_t)(krow0_ + i_ * KRP) * d.ldk + kcol); kreg[i_] = *(const u32x4*)(kb_ + kgo); } } \
            else { kreg[0] = *(const u32x4*)((const char*)(d.K + (size_t)krow0_ * d.ldk + kcol) + kgo); \
                   if (tid < 64 * KCHB) kreg[1] = *(const u32x4*)((const char*)(d.K2 + (size_t)krow0_ * d.ldk2 + d.k2_off) + kgoB); } \
            _Pragma("unroll") for (int i_ = 0; i_ < VI; ++i_) { const char* vb_ = (const char*)(d.V + (size_t)(krow0_ + i_ * VRP) * d.ldv + vcol); vreg[i_] = *(const u32x4*)(vb_ + vgo); } } while (0)
#define ATT_STORE(boff_, kreg, vreg) do { ATT_LOFF(); LAS unsigned char* kb_ = lds + (boff_); \
            if (!K2S) { _Pragma("unroll") for (int i_ = 0; i_ < KI; ++i_) *(LAS u32x4*)(kb_ + i_ * KRP * KP + klo) = kreg[i_]; } \
            else { *(LAS u32x4*)(kb_ + klo) = kreg[0]; if (tid < 64 * KCHB) *(LAS u32x4*)(kb_ + kloB) = kreg[1]; } \
            _Pragma("unroll") for (int i_ = 0; i_ < VI; ++i_) *(LAS u32x4*)(kb_ + KBUF + i_ * VRP * VP + vlo) = vreg[i_]; } while (0)
#define ATT_QKT(P0, P1, boff_) do { const LAS unsigned char* kb_ = lds + (boff_) + r32 * KP + hi * 16; P0 = f32x16{}; P1 = f32x16{}; __builtin_amdgcn_s_setprio(1); \
            _Pragma("unroll") for (int s_ = 0; s_ < NS; ++s_) { const bf16x8 k0_ = *(const LAS bf16x8*)(kb_ + s_ * 32), k1_ = *(const LAS bf16x8*)(kb_ + 32 * KP + s_ * 32); \
                P0 = __builtin_amdgcn_mfma_f32_32x32x16_bf16(k0_, qf[s_], P0, 0, 0, 0); P1 = __builtin_amdgcn_mfma_f32_32x32x16_bf16(k1_, qf[s_], P1, 0, 0, 0); if (s_ & 1) ATT_DSFENCE(); } __builtin_amdgcn_s_setprio(0); } while (0)
#define ATT_MASK(P0, P1, t_) do { \
            if (SWA && (t_) >= 4) { const int kt_ = lat_lo + ((t_) - 4) * 64, qw_ = qb * 256 + wid * 32;     \
                if (kt_ < qw_ - 97 || kt_ > qw_ + 65) {                                                      \
                    if (kt_ > qw_ + 159 || kt_ + 63 < qw_ - 128) { _Pragma("unroll") for (int i_ = 0; i_ < 16; ++i_) { P0[i_] = -1e30f; P1[i_] = -1e30f; } }     \
                    else { const int kp0_ = kt_ + 4 * hi; \
                        _Pragma("unroll") for (int i_ = 0; i_ < 16; ++i_) { const int kp_ = kp0_ + (i_ & 3) + 8 * (i_ >> 2); int dd_ = qpos - kp_; dd_ = dd_ < 0 ? -dd_ : dd_; if (dd_ > 128) P0[i_] = -1e30f; \
                            int d2_ = qpos - kp_ - 32; d2_ = d2_ < 0 ? -d2_ : d2_; if (d2_ > 128) P1[i_] = -1e30f; } } } } } while (0)
          \
#define ATT_PARTIAL0(P0, P1, AL) do { \
            float pm_ = fmaxf(P0[0], P1[0]); \
            _Pragma("unroll") for (int i_ = 1; i_ < 16; ++i_) pm_ = fmaxf(pm_, fmaxf(P0[i_], P1[i_])); \
            pm_ = swapmax(pm_); ms = pm_ * C; AL = 0.f; const float mc_ = -ms; \
            _Pragma("unroll") for (int i_ = 0; i_ < 16; ++i_) { P0[i_] = fmaf(P0[i_], C, mc_); P1[i_] = fmaf(P1[i_], C, mc_); } \
            _Pragma("unroll") for (int i_ = 0; i_ < 16; ++i_) P0[i_] = __builtin_amdgcn_exp2f(P0[i_]); } while (0)
          \
#define ATT_PARTIAL(P0, P1, t_, AL) do { ATT_MASK(P0, P1, t_); \
            const float mc_ = -ms; \
            _Pragma("unroll") for (int i_ = 0; i_ < 16; ++i_) { P0[i_] = fmaf(P0[i_], C, mc_); P1[i_] = fmaf(P1[i_], C, mc_); } \
            float pa_ = fmaxf(fmaxf(P0[0], P1[0]), P0[1]), pb_ = fmaxf(fmaxf(P1[1], P0[2]), P1[2]); \
            _Pragma("unroll") for (int i_ = 3; i_ < 15; i_ += 2) { pa_ = fmaxf(fmaxf(pa_, P0[i_]), P1[i_]); pb_ = fmaxf(fmaxf(pb_, P0[i_ + 1]), P1[i_ + 1]); } \
            float pm_ = fmaxf(fmaxf(pa_, P0[15]), fmaxf(pb_, P1[15])); \
            pm_ = swapmax(pm_); if (SGB) ATT_SGB_PP(); \
            if (__builtin_expect(__all(pm_ <= THRS), 1)) { AL = 1.f; } \
            else { const float dl_ = fmaxf(pm_, 0.f); ms += dl_; AL = __builtin_amdgcn_exp2f(-dl_); \
                _Pragma("unroll") for (int i_ = 0; i_ < 16; ++i_) { P0[i_] -= dl_; P1[i_] -= dl_; } } \
            _Pragma("unroll") for (int i_ = 0; i_ < 16; ++i_) P0[i_] = __builtin_amdgcn_exp2f(P0[i_]); } while (0)
#define ATT_FINISH(P0, P1, AL) do { \
            _Pragma("unroll") for (int i_ = 0; i_ < 16; ++i_) P1[i_] = __builtin_amdgcn_exp2f(P1[i_]); \
            float ps_ = 0.f; \
            _Pragma("unroll") for (int i_ = 0; i_ < 16; ++i_) ps_ += P0[i_] + P1[i_]; \
            l = l * AL + ps_; u32x4 w_; \
            w_.x = cvtpk(P0[0], P0[1]); w_.y = cvtpk(P0[2], P0[3]); w_.z = cvtpk(P0[4], P0[5]); w_.w = cvtpk(P0[6], P0[7]); pf[0] = __builtin_bit_cast(bf16x8, w_); \
            w_.x = cvtpk(P0[8], P0[9]); w_.y = cvtpk(P0[10], P0[11]); w_.z = cvtpk(P0[12], P0[13]); w_.w = cvtpk(P0[14], P0[15]); pf[1] = __builtin_bit_cast(bf16x8, w_); \
            w_.x = cvtpk(P1[0], P1[1]); w_.y = cvtpk(P1[2], P1[3]); w_.z = cvtpk(P1[4], P1[5]); w_.w = cvtpk(P1[6], P1[7]); pf[2] = __builtin_bit_cast(bf16x8, w_); \
            w_.x = cvtpk(P1[8], P1[9]); w_.y = cvtpk(P1[10], P1[11]); w_.z = cvtpk(P1[12], P1[13]); w_.w = cvtpk(P1[14], P1[15]); pf[3] = __builtin_bit_cast(bf16x8, w_); } while (0)
#define ATT_PV(boff_) do { __builtin_amdgcn_s_setprio(1); const LAS unsigned char* vb_ = lds + (boff_) + KBUF + (4 * hi + ((lane & 15) >> 2)) * VP + (16 * ((lane >> 4) & 1) + 4 * (lane & 3)) * 2; \
            _Pragma("unroll") for (int db_ = 0; db_ < ND; ++db_) _Pragma("unroll") for (int ks_ = 0; ks_ < 4; ++ks_) { \
                const s16x4 lo_ = vtr(vb_ + (16 * ks_) * VP + db_ * 64), up_ = vtr(vb_ + (16 * ks_ + 8) * VP + db_ * 64); \
                const bf16x8 vf_ = (bf16x8){lo_[0], lo_[1], lo_[2], lo_[3], up_[0], up_[1], up_[2], up_[3]}; \
                o[db_] = __builtin_amdgcn_mfma_f32_32x32x16_bf16(vf_, pf[ks_], o[db_], 0, 0, 0); if (ks_ & 1) ATT_DSFENCE(); } __builtin_amdgcn_s_setprio(0); } while (0)
#define ATT_SGB_QF() do { _Pragma("unroll") for (int g_ = 0; g_ < 2 * NS; ++g_) { __builtin_amdgcn_sched_group_barrier(0x008, 1, 0); __builtin_amdgcn_sched_group_barrier(0x100, 1, 0); \
            __builtin_amdgcn_sched_group_barrier(0x400, SGB_TQ, 0); __builtin_amdgcn_sched_group_barrier(0x002, SGB_VQ, 0); } } while (0)
#define ATT_SGB_PP() do { _Pragma("unroll") for (int g_ = 0; g_ < 4 * ND; ++g_) { __builtin_amdgcn_sched_group_barrier(0x008, 1, 0); __builtin_amdgcn_sched_group_barrier(0x100, 2, 0); \
            __builtin_amdgcn_sched_group_barrier(0x002, SGB_VP, 0); } } while (0)
#define ATT_OUT(j_) (SWA && (j_) >= 4 && ((lat_lo + ((j_) - 4) * 64) > (qb * 256 + wid * 32) + 159 || (lat_lo + ((j_) - 4) * 64) + 63 < (qb * 256 + wid * 32) - 128))
#define ATT_STEP(C0, C1, ALC, SKC, N0, N1, ALN, SKN, j_, KL, VL, KS, VS) do { SBAR(); if (SD2) { if ((j_) + 2 < NT) ATT_LOAD((j_) + 2, KL, VL); } else { if ((j_) + 1 < NT) ATT_LOAD((j_) + 1, kreg0, vreg0); } SBAR(); \
            SKN = ATT_OUT(j_); \
            if (SEQF) { if (!SKC) ATT_FINISH(C0, C1, ALC); SBAR(); if (!SKN) ATT_QKT(N0, N1, bo_cur); } else { if (!SKN) ATT_QKT(N0, N1, bo_cur); if (!SKC) ATT_FINISH(C0, C1, ALC); if (SGB) ATT_SGB_QF(); } SBAR(); \
            if (!SKC) ATT_PV(bo_prev); if (!SKN) ATT_PARTIAL(N0, N1, j_, ALN); else ALN = 1.f; \
            if ((j_) + 1 < NT) { if (SD2) ATT_STORE(bo_next, KS, VS); else ATT_STORE(bo_next, kreg0, vreg0); } \
            if (__any(ALN < 1.f)) { _Pragma("unroll") for (int i_ = 0; i_ < ND; ++i_) o[i_] *= ALN; } \
            __syncthreads(); { const int t_ = bo_prev; bo_prev = bo_cur; bo_cur = bo_next; bo_next = t_; } } while (0)
        float ms = 0.f, l = 0.f; bool skA = false, skB = false;
        f32x16 o[ND];
#pragma unroll
        for (int i = 0; i < ND; ++i) o[i] = f32x16{};
        f32x16 pA0, pA1, pB0, pB1; float alA = 1.f, alB = 1.f; bf16x8 pf[4];
        int bo_prev = 0, bo_cur = BUFB, bo_next = 2 * BUFB;
        ATT_LOAD(0, kreg0, vreg0); ATT_STORE(0, kreg0, vreg0);
        __syncthreads();
        ATT_QKT(pA0, pA1, 0); ATT_PARTIAL0(pA0, pA1, alA);
        if (SD2) { ATT_LOAD(1, kreg1, vreg1); ATT_STORE(BUFB, kreg1, vreg1); } else { ATT_LOAD(1, kreg0, vreg0); ATT_STORE(BUFB, kreg0, vreg0); }
        if (SD2) ATT_LOAD(2, kreg0, vreg0);
        __syncthreads();
        for (int j = 1; j + 1 < NT; j += 2) {
            ATT_STEP(pA0, pA1, alA, skA, pB0, pB1, alB, skB, j, kreg1, vreg1, kreg0, vreg0);
            ATT_STEP(pB0, pB1, alB, skB, pA0, pA1, alA, skA, j + 1, kreg0, vreg0, kreg1, vreg1);
        }
        ATT_STEP(pA0, pA1, alA, skA, pB0, pB1, alB, skB, NT - 1, kreg1, vreg1, kreg0, vreg0);
        if (!skB) { ATT_FINISH(pB0, pB1, alB); SBAR();
        ATT_PV(bo_prev); }
#undef ATT_LOAD
#undef ATT_STORE
#undef ATT_QKT
#undef ATT_PARTIAL
#undef ATT_PARTIAL0
#undef ATT_MASK
#undef ATT_FINISH
#undef ATT_PV
#undef ATT_STEP
#undef ATT_OUT
        l = swapsum(l);
        if (SWA) l += __builtin_amdgcn_exp2f(d.sink[head] * LOG2E - ms);
        const float inv = __builtin_amdgcn_rcpf(l);
        int lo_ = lane; asm volatile("" : "+v"(lo_));
        bf16* op = d.O + (size_t)(qrow_base + (lo_ & 31)) * d.ldo + he * d.o_mul + 4 * (lo_ >> 5);
        if (!DIFF || sub == 0) {
            bf16* opw = op + 4 * (lo_ >> 5);
#pragma unroll
            for (int db = 0; db < ND; ++db)
#pragma unroll
                for (int g = 0; g < 4; g += 2) {
                    const unsigned ax = cvtpk(o[db][4 * g] * inv, o[db][4 * g + 1] * inv), ay = cvtpk(o[db][4 * g + 2] * inv, o[db][4 * g + 3] * inv);
                    const unsigned bx = cvtpk(o[db][4 * g + 4] * inv, o[db][4 * g + 5] * inv), by = cvtpk(o[db][4 * g + 6] * inv, o[db][4 * g + 7] * inv);
                    const auto r0 = __builtin_amdgcn_permlane32_swap(ax, bx, false, false); const auto r1 = __builtin_amdgcn_permlane32_swap(ay, by, false, false);
                    u32x4 w; w.x = r0[0]; w.y = r1[0]; w.z = r0[1]; w.w = r1[1];
                    *(u32x4*)(opw + db * 32 + 8 * g) = w; }
        } else {
            const float* lm = d.lam;
            const float lamv = __expf(wave_sum(lm[lo_] * lm[64 + lo_])) - __expf(wave_sum(lm[128 + lo_] * lm[192 + lo_])) + d.lam_init;
            const bf16* tpw = op - d.o_mul + 4 * (lo_ >> 5); float ss = 0.f;
#pragma unroll
            for (int db = 0; db < ND; ++db)
#pragma unroll
                for (int g = 0; g < 4; g += 2) { const u32x4 L = *(const u32x4*)(tpw + db * 32 + 8 * g);
                    const auto r0 = __builtin_amdgcn_permlane32_swap(L.x, L.z, false, false); const auto r1 = __builtin_amdgcn_permlane32_swap(L.y, L.w, false, false);
                    const unsigned wa_x = r0[0], wa_y = r1[0], wb_x = r0[1], wb_y = r1[1];
                    { const float v0 = bflo(wa_x) - lamv * (o[db][4 * g] * inv), v1 = bfhi(wa_x) - lamv * (o[db][4 * g + 1] * inv), v2 = bflo(wa_y) - lamv * (o[db][4 * g + 2] * inv), v3 = bfhi(wa_y) - lamv * (o[db][4 * g + 3] * inv);
                      o[db][4 * g] = v0; o[db][4 * g + 1] = v1; o[db][4 * g + 2] = v2; o[db][4 * g + 3] = v3; ss += (v0 * v0 + v1 * v1) + (v2 * v2 + v3 * v3); }
                    { const float v0 = bflo(wb_x) - lamv * (o[db][4 * g + 4] * inv), v1 = bfhi(wb_x) - lamv * (o[db][4 * g + 5] * inv), v2 = bflo(wb_y) - lamv * (o[db][4 * g + 6] * inv), v3 = bfhi(wb_y) - lamv * (o[db][4 * g + 7] * inv);
                      o[db][4 * g + 4] = v0; o[db][4 * g + 5] = v1; o[db][4 * g + 6] = v2; o[db][4 * g + 7] = v3; ss += (v0 * v0 + v1 * v1) + (v2 * v2 + v3 * v3); } }
            ss = swapsum(ss);
            const float rn = __builtin_amdgcn_rsqf(ss * (1.0f / 128.0f) + EPS) * (1.0f - d.lam_init);
            bf16* op2 = d.O2 + (size_t)(qrow_base + (lo_ & 31)) * DM + head * 128 + 4 * (lo_ >> 5);
            bf16* op2w = op2 + 4 * (lo_ >> 5);
#pragma unroll
            for (int db = 0; db < ND; ++db)
#pragma unroll
                for (int g = 0; g < 4; g += 2) { const f32x4 ga = *(const f32x4*)(d.aux + db * 32 + 8 * g + 4 * (lo_ >> 5)), gb = *(const f32x4*)(d.aux + db * 32 + 8 * g + 8 + 4 * (lo_ >> 5));
                    const unsigned ax = cvtpk(o[db][4 * g] * rn * ga.x, o[db][4 * g + 1] * rn * ga.y), ay = cvtpk(o[db][4 * g + 2] * rn * ga.z, o[db][4 * g + 3] * rn * ga.w);
                    const unsigned bx = cvtpk(o[db][4 * g + 4] * rn * gb.x, o[db][4 * g + 5] * rn * gb.y), by = cvtpk(o[db][4 * g + 6] * rn * gb.z, o[db][4 * g + 7] * rn * gb.w);
                    const auto r0 = __builtin_amdgcn_permlane32_swap(ax, bx, false, false); const auto r1 = __builtin_amdgcn_permlane32_swap(ay, by, false, false);
                    u32x4 w; w.x = r0[0]; w.y = r1[0]; w.z = r0[1]; w.w = r1[1];
                    *(u32x4*)(op2w + db * 32 + 8 * g) = w; }
        }
        asm volatile("s_waitcnt lgkmcnt(0)\n\ts_barrier" ::: "memory");
        }
    }
}

typedef __attribute__((address_space(1))) unsigned gu32;
#define XB_TMO      128
#define XB_XCNT(j)  (256  + 64 * (j))
#define XB_XSUB(j)  (1280 + 64 * (j))
#define XB_XGEN(j)  (2304 + 64 * (j))
#define XB_TOP      3328
#define XB_TOPGEN   3392
#define XCD_BAR_WORDS 3456
#define XB_SPIN_CAP (1u << 18)

__device__ __forceinline__ unsigned xb_ld(unsigned* p)              { return __hip_atomic_load(p, __ATOMIC_RELAXED, __HIP_MEMORY_SCOPE_AGENT); }
__device__ __forceinline__ unsigned xb_add(unsigned* p, unsigned v) { return __hip_atomic_fetch_add(p, v, __ATOMIC_RELAXED, __HIP_MEMORY_SCOPE_AGENT); }
__device__ __forceinline__ unsigned xb_xcc_id() { return (unsigned)__builtin_amdgcn_s_getreg((3 << 11) | 20) & 0xFu; }
#define XB_SPIN(cond, bar) do { unsigned _sp = 0; while (cond) { __builtin_amdgcn_s_sleep(1); \
    if ((++_sp & 255u) == 0u) { if (xb_ld(&(bar)[XB_TMO])) break; if (_sp > XB_SPIN_CAP) { atomicAdd(&(bar)[XB_TMO], 1u); break; } } } } while (0)

struct XcdBarrier {
    unsigned* bar; unsigned x;
    volatile LAS unsigned* st;
};

__device__ __forceinline__ XcdBarrier xcd_barrier_post(unsigned* bar, volatile LAS unsigned* st) {
    XcdBarrier b; b.bar = bar; b.x = xb_xcc_id(); b.st = st;
    if (threadIdx.x == 0) (void)xb_add(&bar[XB_XCNT(b.x)], 1u);
    return b;
}
__device__ __forceinline__ void xcd_barrier_complete(unsigned* bar, unsigned x, unsigned& nloc, unsigned& nx) {
    const unsigned G = gridDim.x * gridDim.y * gridDim.z;
    unsigned sum, cnt, mine, sp = 0u;
    for (;;) {
        sum = 0u; cnt = 0u; mine = 0u;
#pragma unroll
        for (unsigned j = 0; j < 16; ++j) { const unsigned c = xb_ld(&bar[XB_XCNT(j)]); sum += c; cnt += (c > 0u) ? 1u : 0u; mine = (j == x) ? c : mine; }
        if (sum == G) break;
        __builtin_amdgcn_s_sleep(1);
        if ((++sp & 255u) == 0u) { if (xb_ld(&bar[XB_TMO])) break; if (sp > XB_SPIN_CAP) { atomicAdd(&bar[XB_TMO], 1u); break; } }
    }
    nloc = mine > 0u ? mine : 1u; nx = cnt > 0u ? cnt : 1u;
}

__device__ __forceinline__ void xcd_barrier(const XcdBarrier& b) {
    asm volatile("s_waitcnt vmcnt(0)" ::: "memory");
    __syncthreads();
    if (threadIdx.x == 0) {
        unsigned* bar = b.bar;
        __builtin_amdgcn_s_waitcnt(0);
        unsigned nloc = b.st[0], nx = b.st[1];
        if (nloc == 0u) { xcd_barrier_complete(bar, b.x, nloc, nx); b.st[0] = nloc; b.st[1] = nx; }
        const unsigned old = xb_add(&bar[XB_XSUB(b.x)], 1u);
        const unsigned gen = old / nloc;
        if (old + 1u == (gen + 1u) * nloc) {
            __builtin_amdgcn_fence(__ATOMIC_RELEASE, "agent");
            asm volatile("s_waitcnt vmcnt(0)" ::: "memory");
            const unsigned og = xb_add(&bar[XB_TOP], 1u);
            const unsigned tg = og / nx;
            if (og + 1u == (tg + 1u) * nx) xb_add(&bar[XB_TOPGEN], 1u);
            else XB_SPIN(xb_ld(&bar[XB_TOPGEN]) == tg, bar);
            __builtin_amdgcn_fence(__ATOMIC_ACQUIRE, "agent");
            xb_add(&bar[XB_XGEN(b.x)], 1u);
            asm volatile("s_waitcnt vmcnt(0)" ::: "memory");
        } else {
            XB_SPIN(xb_ld(&bar[XB_XGEN(b.x)]) == gen, bar);
            __builtin_amdgcn_fence(__ATOMIC_ACQUIRE, "agent");
            asm volatile("s_waitcnt vmcnt(0)" ::: "memory");
        }
    }
    __syncthreads();
}

#ifndef GALIGN
#define GALIGN true
#endif
#ifndef GSP2
#define GSP2 true
#endif
template <class T> __device__ __forceinline__ T* uptr(T* q) {
    const unsigned long long v = (unsigned long long)q; const unsigned lo = __builtin_amdgcn_readfirstlane((unsigned)v), hi = __builtin_amdgcn_readfirstlane((unsigned)(v >> 32));
    return (T*)(__attribute__((address_space(1))) T*)(((unsigned long long)hi << 32) | lo); }
#define LOADP() Params p; { auto q_ = __builtin_amdgcn_kernarg_segment_ptr(); asm volatile("" : "+s"(q_)); __builtin_memcpy(&p, (const void*)q_, sizeof(Params)); } \
    unsigned char* const ws = uptr(p.ws); const int G = gridDim.x; (void)ws; (void)G
#define GSYNC_CG() cg::this_grid().sync()
#define GSYNC() do { LOADP(); XcdBarrier b_; b_.bar = (unsigned*)(ws + WS_BAR); b_.x = xb_xcc_id(); b_.st = (volatile LAS unsigned*)(lds + 131072 + 32); xcd_barrier(b_); } while (0)
__global__ void __launch_bounds__(NTHREADS, 2) fwd_megakernel(Params p_unused) {
    extern __shared__ __attribute__((aligned(16))) unsigned char lds_raw[];
    LAS unsigned char* lds = (LAS unsigned char*)lds_raw;
    if (tid_opaque() < 16) ((LAS unsigned*)(lds + 131072))[tid_opaque()] = 0u;
    __syncthreads();
    { LOADP(); (void)xcd_barrier_post((unsigned*)(ws + WS_BAR), (volatile LAS unsigned*)(lds + 131072 + 32)); }
#ifndef NO_P0
    { LOADP(); phase0(p, lds, G); }
#endif
    GSYNC_CG();
    { LOADP(); phase0b(p, G); }
    GSYNC();
    { LOADP(); rowop<true, false, true>(p, G, MT, 0.f, nullptr, 0, nullptr, (const float*)(ws + WS_MOD), 0, p.norm_g); }
    GSYNC();

#pragma unroll 1
    for (int layer = 0; layer < 4; ++layer) {
#pragma unroll 1
        for (int half = 0; half < 2; ++half) {
            if (half == 1) {
                const int nsteps = layer == 2 ? 3 : 1;
#pragma unroll 1
                for (int s = 0; s < nsteps; ++s) {
#ifndef NO_G3
                    { LOADP(); bf16* A = (bf16*)(ws + WS_A); bf16* U = (bf16*)(ws + WS_U);
                      pg8::Gemm g; pg8::EpiBf16Rope E;
                      if (layer == 0)      { g = pg8::Gemm{A, (const bf16*)(ws + WS_DA_IN), MT, 3072, 1024}; E = pg8::EpiBf16Rope{U, 3072, 1, 2048, NL / 256}; }
                      else if (layer == 1) { g = pg8::Gemm{A, (const bf16*)(ws + WS_GA_IN), MT, 1536, 1024}; E = pg8::EpiBf16Rope{U, 1536, 0, 0, 0}; }
                      else if (layer == 3) { g = pg8::Gemm{A, (const bf16*)(ws + WS_SWA_IN), MT, 1280, 1024}; E = pg8::EpiBf16Rope{U, 1280, 1, 1152, NL / 256}; }
                      else if (s == 0)     { g = pg8::Gemm{A, (const bf16*)(ws + WS_MLA_IN), MT, 512, 1024}; E = pg8::EpiBf16Rope{(bf16*)(ws + WS_CIN), 512, 0, 0, 0}; }
                      else if (s == 1)     { g = pg8::Gemm{(const bf16*)(ws + WS_AQ), (const bf16*)(ws + WS_MLA_UQ), MT, 1536, 256}; E = pg8::EpiBf16Rope{(bf16*)(ws + WS_MQ), 1536, 2, 0, NL / 256}; }
                      else                 { g = pg8::Gemm{(const bf16*)(ws + WS_AKV), (const bf16*)(ws + WS_MLA_UKV), MT, 2048, 128};     E = pg8::EpiBf16Rope{(bf16*)(ws + WS_MKV), 2048, 0, 0, 0}; }
                      pg8::StaticOrder S; S.init(g.M, g.N, G, (int)bid_opaque());
                      pg8::gemm_phase<pg8::EpiBf16Rope, pg8::StaticOrder, GALIGN, GSP2>(lds, g, S, E); }
#endif
                    if (layer == 2 && s == 1) continue;
                    GSYNC();
                    if (layer == 1 || (layer == 2 && s == 0)) {
                        { LOADP();
                          if (layer == 1) post_ga(p, G);
                          else post_mla1(p, G); }
                        GSYNC();
                    }
                }
                if (layer == 0) {
#ifndef NO_ATT0
                    { LOADP(); const bf16* U = (const bf16*)(ws + WS_U);
                      AttnDesc d{U, U, U, U, (bf16*)(ws + WS_Y), 3072, 3072, 0, 3072, 2048, 8, 64, 1024, 1, 64, 0, 2048, 2, 128, 128, 0.125f, nullptr, (bf16*)(ws + WS_A), uptr(p.da_subln), uptr(p.da_lambda), 0.8f - 0.6f};
                      attn_phase<64, 64, 128, false, true>(lds, d, true, G); }
#endif
                } else if (layer == 1) {
#ifndef NO_ATT1
                    { LOADP(); const bf16* U = (const bf16*)(ws + WS_U);
                      AttnDesc d{U, U, U, U, (bf16*)(ws + WS_A), 1536, 1536, 0, 1536, 1024, 8, 128, 1024, 4, 128, 0, 1280, 4, 128, 128, 0.08838834764831845f, nullptr, nullptr, uptr(p.ga_q_norm), nullptr, 0.f};
                      attn_phase<128, 128, 128, false>(lds, d, true, G); }
#endif
                } else if (layer == 2) {
#ifndef NO_ATT2
                    { LOADP(); const bf16* q = (const bf16*)(ws + WS_MQ); const bf16* kv = (const bf16*)(ws + WS_MKV);
                      AttnDesc d{q, kv, (const bf16*)(ws + WS_CIN), kv, (bf16*)(ws + WS_A), 1536, 2048, 512, 2048, 1024, 16, 96, 0, 1, 128, 384, 64, 1, 128, 64, 0.10206207261596575f, nullptr};
                      attn_phase<96, 64, 64, false>(lds, d, true, G); }
#endif
                } else {
#ifndef NO_ATT3
                    { LOADP(); const bf16* U = (const bf16*)(ws + WS_U);
                      AttnDesc d{U, U, U, U, (bf16*)(ws + WS_A), 1280, 1280, 0, 1280, 1024, 16, 64, 1024, 8, 64, 0, 1152, 8, 64, 64, 0.125f, p.swa_sink};
                      attn_phase<64, 64, 64, true>(lds, d, false, G); }
#endif
                }
                GSYNC();
#ifndef NO_G4
                { LOADP();
                  const size_t wo = layer == 0 ? WS_DA_OUT : layer == 1 ? WS_GA_OUT : layer == 2 ? WS_MLA_OUT : WS_SWA_OUT;
                  pg8::Gemm g{(const bf16*)(ws + WS_A), (const bf16*)(ws + wo), layer < 3 ? MT : NL, 1024, 1024}; pg8::EpiBf16S E{(bf16*)(ws + WS_Y), 1024};
                  pg8::StaticOrder S; S.init(g.M, g.N, G, (int)bid_opaque());
                  pg8::gemm_phase<pg8::EpiBf16S, pg8::StaticOrder, GALIGN, GSP2>(lds, g, S, E); }
#endif
                GSYNC();
                { LOADP(); const float* gl = p.norm_g + (size_t)layer * 6 * DM; const float* modl = (const float*)(ws + WS_MOD) + (size_t)layer * 9 * NMOD;
                  rowop<false, true, true>(p, G, layer < 3 ? MT : NL, 1.0f, modl, 5, gl + 3 * DM, modl, 6, gl + 4 * DM); }
                GSYNC();
            }
#ifndef NO_G1
            { LOADP();
              pg8::Gemm g{(const bf16*)(ws + WS_A), (const bf16*)(ws + WS_FIN + (size_t)(layer * 2 + half) * FIN_BYTES), (half == 0 || layer < 3) ? MT : NL, 2 * DFF, 1024}; pg8::EpiSwiGLU E{(bf16*)(ws + WS_U), DFF};
              pg8::StaticOrder S; S.init(g.M, g.N, G, (int)bid_opaque());
              pg8::gemm_phase<pg8::EpiSwiGLU, pg8::StaticOrder, GALIGN, GSP2>(lds, g, S, E); }
#endif
            GSYNC();
#define ROWOP_FFN(row0_, nrows_, gw_, ngw_) do { const float* gl = p.norm_g + (size_t)layer * 6 * DM; const float* modl = (const float*)(ws + WS_MOD) + (size_t)layer * 9 * NMOD; \
              if (half == 0) rowop_rows<false, true, true>(p, row0_, nrows_, gw_, ngw_, 0.5f, modl, 2, gl + 1 * DM, modl, 3, gl + 2 * DM); \
              else if (layer < 3) rowop_rows<false, true, true>(p, row0_, nrows_, gw_, ngw_, 0.5f, modl, 8, gl + 5 * DM, modl + 9 * NMOD, 0, gl + 6 * DM); \
              else rowop_rows<false, true, false>(p, row0_, nrows_, gw_, ngw_, 0.5f, modl, 8, gl + 5 * DM, nullptr, 0, nullptr); } while (0)
            { const bool wctx = (half == 0 || layer < 3);
#pragma unroll 1
              for (int pass = 0; pass < (wctx ? 2 : 1); ++pass) {
                  if (pass == 0 || (int)bid_opaque() < 32) {
#ifndef NO_G2
                      { LOADP();
                        pg8::Gemm g{(const bf16*)(ws + WS_U) + (pass ? (size_t)NL * DFF : 0), (const bf16*)(ws + WS_FOUT + (size_t)(layer * 2 + half) * FOUT_BYTES), pass ? NC : NL, 1024, DFF};
                        pg8::EpiBf16S E{(bf16*)(ws + WS_Y) + (pass ? (size_t)NL * DM : 0), 1024};
                        pg8::StaticOrder S; S.init(g.M, g.N, pass ? 32 : G, (int)bid_opaque());
                        pg8::gemm_phase<pg8::EpiBf16S, pg8::StaticOrder, GALIGN, GSP2>(lds, g, S, E); }
#endif
                  } else { LOADP(); ROWOP_FFN(0, NL, ((int)bid_opaque() - 32) * 8 + (tid_opaque() >> 6), (G - 32) * 8); }
                  GSYNC();
              }
              { LOADP(); if (wctx) ROWOP_FFN(NL, NC, (int)bid_opaque() * 8 + (tid_opaque() >> 6), G * 8); else ROWOP_FFN(0, NL, (int)bid_opaque() * 8 + (tid_opaque() >> 6), G * 8); }
              if (!(layer == 3 && half == 1)) GSYNC();
            }
#undef ROWOP_FFN
        }
    }
}

extern "C" void kernel_launch(void* const* d_in, const int* in_sizes, int n_in, void* d_out, int out_size, void* d_ws, size_t ws_size, hipStream_t stream) {
    static int grid_blocks = 0;
    if (grid_blocks == 0) {
        if (n_in != 26 || out_size != NL * DM || ws_size < WS_END) { fprintf(stderr, "kernel_launch: unexpected shapes (n_in %d, out %d, ws %zu)\n", n_in, out_size, ws_size); grid_blocks = -1; return; }
        int dev = 0, cus = 0, per_cu = 0;
        hipGetDevice(&dev);
        hipDeviceGetAttribute(&cus, hipDeviceAttributeMultiprocessorCount, dev);
        if (hipFuncSetAttribute((const void*)fwd_megakernel, hipFuncAttributeMaxDynamicSharedMemorySize, LDS_BYTES) != hipSuccess) { fprintf(stderr, "kernel_launch: hipFuncSetAttribute failed\n"); grid_blocks = -1; return; }
        if (hipOccupancyMaxActiveBlocksPerMultiprocessor(&per_cu, (const void*)fwd_megakernel, NTHREADS, LDS_BYTES) != hipSuccess || per_cu < 1) { fprintf(stderr, "kernel_launch: occupancy query failed (%d)\n", per_cu); per_cu = 1; (void)hipGetLastError(); }
        grid_blocks = cus * (per_cu > 1 ? 1 : per_cu);
    }
    if (grid_blocks < 0) return;
    Params p{};
    const float** pp = (const float**)&p;
    for (int i = 0; i < 26; ++i) pp[i] = (const float*)d_in[i];
    p.out = (float*)d_out; p.ws = (unsigned char*)d_ws;
    if (hipMemsetAsync((char*)d_ws + WS_BAR, 0, XCD_BAR_WORDS * 4, stream) != hipSuccess) { fprintf(stderr, "kernel_launch: memset failed\n"); return; }
    void* args[] = {&p};
    hipError_t e = hipLaunchCooperativeKernel((const void*)fwd_megakernel, dim3(grid_blocks), dim3(NTHREADS), args, LDS_BYTES, stream);
    if (e != hipSuccess) fprintf(stderr, "cooperative launch failed: %s (grid %d)\n", hipGetErrorString(e), grid_blocks);
}
```

```cpp
#include <hip/hip_runtime.h>
#include <hip/hip_cooperative_groups.h>
#include <cstdio>
#include <cstdint>
#include <cmath>
namespace cg = cooperative_groups;
__device__ __forceinline__ int tid_opaque() { int t = threadIdx.x; asm volatile("" : "+v"(t)); return t; }
__device__ __forceinline__ int bid_opaque() { int b = blockIdx.x; asm volatile("" : "+s"(b)); return b; }
namespace pg8 {
#define PG8_LAS __attribute__((address_space(3)))
typedef unsigned short bf16_t;
typedef short bf16x8 __attribute__((ext_vector_type(8)));
typedef float f32x4 __attribute__((ext_vector_type(4)));
typedef unsigned u32x4 __attribute__((ext_vector_type(4)));
constexpr int BM = 256, BK = 64, HALF = 128, HTB = HALF * BK * 2  , STAGE_BYTES = 8 * HTB, NXCD = 8, WGM = 8;

__host__ __device__ __forceinline__ int lds_byte(int r, int c) { const int st = (r >> 4) * 2 + (c >> 5), rr = r & 15, cc = c & 31, ob = rr * 64 + cc * 2; return st * 1024 + (ob ^ (((ob >> 9) & 1) << 5)); }
__host__ __device__ __forceinline__ void stage_rc(int b, int& R, int& C) { const int st = b / 1024, sb = b % 1024, swz = sb ^ (((sb >> 9) & 1) << 5); R = (st >> 1) * 16 + swz / 64; C = (st & 1) * 32 + (swz % 64) / 2; }
__host__ __device__ __forceinline__ int perm32(int rho) { const int n = rho >> 4, i = rho & 15; return 8 * (i >> 2) + 4 * n + (i & 3); }

struct Unit { int pm, pn; };
struct Gemm { const bf16_t* A; const bf16_t* Bt; int M, N, K; };

struct StaticOrder {
    int nM, nN, nwg, G, c;
    __host__ __device__ void init(int M, int N, int G_, int c_) { nM = M / BM; nN = N / BM; nwg = nM * nN; G = G_; c = c_; }
    __host__ __device__ bool next(int i, Unit& u) const {
        const long L = (long)i * G + c; if (L >= nwg) return false;
        int wgid = (int)L; { const int q = nwg / NXCD, r = nwg % NXCD, xcd = wgid % NXCD, off = wgid / NXCD; wgid = (xcd < r ? xcd * (q + 1) : r * (q + 1) + (xcd - r) * q) + off; }
        const int nig = WGM * nN, gid = wgid / nig, fm = gid * WGM, gsz = (nM - fm) < WGM ? (nM - fm) : WGM;
        u.pm = fm + ((wgid % nig) % gsz); u.pn = (wgid % nig) / gsz; return true;
    }
    __device__ __forceinline__ void a_ready(const Unit&) const {}
    __device__ __forceinline__ void done(const Unit&) const {}
};

__device__ __forceinline__ unsigned cvt_pk_bf16(float lo, float hi) { unsigned r; asm volatile("v_cvt_pk_bf16_f32 %0, %1, %2" : "=v"(r) : "v"(lo), "v"(hi)); return r; }
struct EpiBf16S {
    static constexpr bool PERM = true, AFTER_DRAIN = false;
    bf16_t* O; int ldc;
    __device__ __forceinline__ void operator()(const f32x4 (&acc)[2][2][4][2], const Unit& u, int wr, int wc, int fr, int fq) const {
        const int row0 = u.pm * BM + wr * 64 + fr; const int col0 = u.pn * BM + wc * 32 + 8 * fq;
#pragma unroll
        for (int ai = 0; ai < 2; ++ai)
#pragma unroll
            for (int m = 0; m < 4; ++m) { bf16_t* rowp = O + (size_t)(row0 + ai * HALF + m * 16) * ldc + col0;
#pragma unroll
                for (int bj = 0; bj < 2; ++bj) { const f32x4 v0 = acc[ai][bj][m][0], v1 = acc[ai][bj][m][1];
                    u32x4 w; w.x = cvt_pk_bf16(v0[0], v0[1]); w.y = cvt_pk_bf16(v0[2], v0[3]); w.z = cvt_pk_bf16(v1[0], v1[1]); w.w = cvt_pk_bf16(v1[2], v1[3]);
                    *(u32x4*)(rowp + bj * HALF) = w; } }
    }
};
__device__ __forceinline__ float silu_mul(float g, float u) { return g * __builtin_amdgcn_rcpf(1.0f + __builtin_amdgcn_exp2f(-1.4426950408889634f * g)) * u; }
struct EpiSwiGLU {
    static constexpr bool PERM = true, AFTER_DRAIN = false;
    bf16_t* O; int ldc;
    __device__ __forceinline__ void operator()(const f32x4 (&acc)[2][2][4][2], const Unit& u, int wr, int wc, int fr, int fq) const {
        const int row0 = u.pm * BM + wr * 64 + fr; const int col0 = u.pn * HALF + wc * 32 + 8 * fq;
#pragma unroll
        for (int ai = 0; ai < 2; ++ai)
#pragma unroll
            for (int m = 0; m < 4; ++m) { bf16_t* rowp = O + (size_t)(row0 + ai * HALF + m * 16) * ldc + col0;
                const f32x4 g0 = acc[ai][0][m][0], g1 = acc[ai][0][m][1], u0 = acc[ai][1][m][0], u1 = acc[ai][1][m][1];
                u32x4 w;
                w.x = cvt_pk_bf16(silu_mul(g0[0], u0[0]), silu_mul(g0[1], u0[1])); w.y = cvt_pk_bf16(silu_mul(g0[2], u0[2]), silu_mul(g0[3], u0[3]));
                w.z = cvt_pk_bf16(silu_mul(g1[0], u1[0]), silu_mul(g1[1], u1[1])); w.w = cvt_pk_bf16(silu_mul(g1[2], u1[2]), silu_mul(g1[3], u1[3]));
                *(u32x4*)rowp = w; }
    }
};
struct EpiF32 {
    static constexpr bool PERM = false, AFTER_DRAIN = false;
    float* O; int ldc;
    __device__ __forceinline__ void operator()(const f32x4 (&acc)[2][2][4][2], const Unit& u, int wr, int wc, int fr, int fq) const {
        const int col0 = u.pn * BM + wc * 32 + 4 * fq;
#pragma unroll
        for (int ai = 0; ai < 2; ++ai)
#pragma unroll
            for (int m = 0; m < 4; ++m) { float* rowp = O + (size_t)(u.pm * BM + ai * HALF + wr * 64 + m * 16 + fr) * ldc + col0;
#pragma unroll
                for (int bj = 0; bj < 2; ++bj)
#pragma unroll
                    for (int n = 0; n < 2; ++n) *(f32x4*)(rowp + bj * HALF + n * 16) = acc[ai][bj][m][n]; }
    }
};

struct EpiBf16Rope {
    static constexpr bool PERM = true, AFTER_DRAIN = false;
    bf16_t* O; int ldc; int mode; int col_limit; int lat_panels;
    __device__ __forceinline__ void operator()(const f32x4 (&acc)[2][2][4][2], const Unit& u, int wr, int wc, int fr, int fq) const {
        const int row0 = u.pm * BM + wr * 64 + fr; const int col0 = u.pn * BM + wc * 32 + 8 * fq;
        const bool lat = mode != 0 && u.pm < lat_panels;
        bool rot[2]; float fr4[2][4]; bool rowaxis[2];
#pragma unroll
        for (int bj = 0; bj < 2; ++bj) { const int col = col0 + bj * HALF; int j0, nax;
            if (mode == 2) { const int c96 = col % 96; rot[bj] = lat && c96 >= 64; j0 = (c96 - 64) >> 1; nax = 8; }
            else { rot[bj] = lat && col < col_limit; j0 = (col & 63) >> 1; nax = 16; }
            rowaxis[bj] = j0 < nax; const int f0 = j0 & (nax - 1);
#pragma unroll
            for (int e = 0; e < 4; ++e) fr4[bj][e] = __builtin_amdgcn_exp2f(-13.287712379549449f * (float)(f0 + e) / (float)nax); }
#pragma unroll
        for (int ai = 0; ai < 2; ++ai)
#pragma unroll
            for (int m = 0; m < 4; ++m) { const int row = row0 + ai * HALF + m * 16; bf16_t* rowp = O + (size_t)row * ldc + col0;
                const int s = row & 4095; const float prow = (float)(s >> 6), pcol = (float)(s & 63);
#pragma unroll
                for (int bj = 0; bj < 2; ++bj) { f32x4 v0 = acc[ai][bj][m][0], v1 = acc[ai][bj][m][1];
                    if (rot[bj]) { const float pos = rowaxis[bj] ? prow : pcol;
                        float cs, sn, t;
                        cs = __cosf(pos * fr4[bj][0]); sn = __sinf(pos * fr4[bj][0]); t = v0[0] * cs - v0[1] * sn; v0[1] = v0[0] * sn + v0[1] * cs; v0[0] = t;
                        cs = __cosf(pos * fr4[bj][1]); sn = __sinf(pos * fr4[bj][1]); t = v0[2] * cs - v0[3] * sn; v0[3] = v0[2] * sn + v0[3] * cs; v0[2] = t;
                        cs = __cosf(pos * fr4[bj][2]); sn = __sinf(pos * fr4[bj][2]); t = v1[0] * cs - v1[1] * sn; v1[1] = v1[0] * sn + v1[1] * cs; v1[0] = t;
                        cs = __cosf(pos * fr4[bj][3]); sn = __sinf(pos * fr4[bj][3]); t = v1[2] * cs - v1[3] * sn; v1[3] = v1[2] * sn + v1[3] * cs; v1[2] = t; }
                    u32x4 w; w.x = cvt_pk_bf16(v0[0], v0[1]); w.y = cvt_pk_bf16(v0[2], v0[3]); w.z = cvt_pk_bf16(v1[0], v1[1]); w.w = cvt_pk_bf16(v1[2], v1[3]);
                    *(u32x4*)(rowp + bj * HALF) = w; } }
    }
};
template <class Epi, class Sched, bool ALIGN_EPI = false, bool SP2 = false>
__device__ __forceinline__ void gemm_phase(PG8_LAS unsigned char* lds, const Gemm g, const Sched& S, const Epi& E) {
    const int tid = tid_opaque(), wid = __builtin_amdgcn_readfirstlane(tid >> 6), lane = tid & 63, wr = wid >> 2, wc = wid & 3, fr = lane & 15, fq = lane >> 4;
    const int K = g.K, nt = K / BK;
    unsigned voffA[2], voffB[2];
#pragma unroll
    for (int i = 0; i < 2; ++i) { int R, C; stage_rc(tid * 16 + i * 8192, R, C); const int Rb = Epi::PERM ? ((R & ~31) + perm32(R & 31)) : R;
        voffA[i] = (unsigned)(R * K + C) * 2u; voffB[i] = (unsigned)(Rb * K + C) * 2u; }
    const size_t kstep = (size_t)(BK * 2);
    const size_t hstep = (size_t)HALF * K * 2;
    const size_t tstep = 2 * hstep;
    const unsigned ldsw = (unsigned)wid * 1024u;
    const int aoff = lds_byte(wr * 64 + fr, fq * 8), boff = lds_byte(wc * 32 + fr, fq * 8);
#define PG8_SA(b, h) (((b) * 2 + (h)) * HTB)
#define PG8_SB(b, h) ((4 + (b) * 2 + (h)) * HTB)
#define PG8_STAGE(bufoff, gbase, voff) do { _Pragma("unroll") for (int _i = 0; _i < 2; ++_i) \
        __builtin_amdgcn_global_load_lds((const unsigned*)((const char*)(gbase) + (voff)[_i]), (PG8_LAS unsigned*)(lds + (bufoff) + ldsw + _i * 8192), 16, 0, 0); } while (0)
#define PG8_LDA(dst, b, h) do { _Pragma("unroll") for (int m = 0; m < 4; ++m) _Pragma("unroll") for (int k = 0; k < 2; ++k) dst[m][k] = *(const PG8_LAS bf16x8*)(lds + PG8_SA(b, h) + aoff + m * 2048 + k * 1024); } while (0)
#define PG8_LDB(dst, b, h) do { _Pragma("unroll") for (int n = 0; n < 2; ++n) _Pragma("unroll") for (int k = 0; k < 2; ++k) dst[n][k] = *(const PG8_LAS bf16x8*)(lds + PG8_SB(b, h) + boff + n * 2048 + k * 1024); } while (0)
#define PG8_MMA(ai, bj, At, Bt) do { __builtin_amdgcn_s_setprio(1); _Pragma("unroll") for (int m = 0; m < 4; ++m) _Pragma("unroll") for (int n = 0; n < 2; ++n) _Pragma("unroll") for (int k = 0; k < 2; ++k) \
        acc[ai][bj][m][n] = __builtin_amdgcn_mfma_f32_16x16x32_bf16(Bt[n][k], At[m][k], acc[ai][bj][m][n], 0, 0, 0); __builtin_amdgcn_s_setprio(0); } while (0)
#define PG8_WAIT_V(n) asm volatile("s_waitcnt vmcnt(" #n ")" ::: "memory")
#define PG8_WAIT_L(n) asm volatile("s_waitcnt lgkmcnt(" #n ")" ::: "memory")
#define PG8_BAR __builtin_amdgcn_s_barrier()
#define PG8_SCHED __builtin_amdgcn_sched_barrier(0)
    Unit cur, nxt; int ui = 0;
    if (!S.next(0, cur)) return;
    f32x4 acc[2][2][4][2];
#pragma unroll
    for (int a = 0; a < 2; ++a)
#pragma unroll
        for (int b = 0; b < 2; ++b)
#pragma unroll
            for (int m = 0; m < 4; ++m)
#pragma unroll
                for (int n = 0; n < 2; ++n) acc[a][b][m][n] = (f32x4){0.f, 0.f, 0.f, 0.f};
    bf16x8 At[4][2], B0[2][2], B1[2][2];
    const char* cA = (const char*)g.A + (size_t)cur.pm * tstep; const char* cB = (const char*)g.Bt + (size_t)cur.pn * tstep;
    S.a_ready(cur);
    if constexpr (SP2) {
        PG8_STAGE(PG8_SB(0, 0), cB, voffB); PG8_STAGE(PG8_SB(0, 1), cB + hstep, voffB); PG8_STAGE(PG8_SA(0, 0), cA, voffA); PG8_STAGE(PG8_SA(0, 1), cA + hstep, voffA);
        if (wr == 1) PG8_BAR;
        PG8_WAIT_V(2); PG8_BAR;
        PG8_STAGE(PG8_SB(1, 0), cB + kstep, voffB); PG8_STAGE(PG8_SA(1, 0), cA + kstep, voffA); PG8_STAGE(PG8_SB(1, 1), cB + hstep + kstep, voffB);
        PG8_WAIT_V(6); PG8_BAR;
    } else {
        PG8_STAGE(PG8_SB(0, 0), cB, voffB); PG8_STAGE(PG8_SA(0, 0), cA, voffA); PG8_STAGE(PG8_SB(0, 1), cB + hstep, voffB); PG8_STAGE(PG8_SA(0, 1), cA + hstep, voffA);
        if (wr == 1) PG8_BAR;
        PG8_WAIT_V(4); PG8_BAR;
        PG8_STAGE(PG8_SB(1, 0), cB + kstep, voffB); PG8_STAGE(PG8_SA(1, 0), cA + kstep, voffA); PG8_STAGE(PG8_SB(1, 1), cB + hstep + kstep, voffB);
        PG8_WAIT_V(6); PG8_BAR;
    }
    for (;;) {
        const bool has_next = S.next(ui + 1, nxt);
        const char* nA = has_next ? (const char*)g.A + (size_t)nxt.pm * tstep : cA; const char* nB = has_next ? (const char*)g.Bt + (size_t)nxt.pn * tstep : cB;
        for (int t = 0; t < nt; t += 2) {
            const bool last = (t == nt - 2);
            const char* a1 = cA + (size_t)(t + 1) * kstep;
            const char* a2 = last ? nA : cA + (size_t)(t + 2) * kstep; const char* b2 = last ? nB : cB + (size_t)(t + 2) * kstep;
            const char* a3 = a2 + kstep; const char* b3 = b2 + kstep;
            if (last && has_next) S.a_ready(nxt);
            if constexpr (SP2) {
            PG8_LDB(B0, 0, 0); PG8_LDB(B1, 0, 1); PG8_SCHED; PG8_LDA(At, 0, 0); PG8_STAGE(PG8_SA(1, 1), a1 + hstep, voffA);
            PG8_WAIT_V(8); PG8_WAIT_L(0); PG8_BAR; PG8_MMA(0, 0, At, B0); PG8_MMA(0, 1, At, B1); PG8_BAR; PG8_SCHED;
            PG8_LDA(At, 0, 1); PG8_STAGE(PG8_SB(0, 0), b2, voffB); PG8_STAGE(PG8_SB(0, 1), b2 + hstep, voffB); PG8_STAGE(PG8_SA(0, 0), a2, voffA);
            PG8_WAIT_V(8); PG8_WAIT_L(0); PG8_BAR; PG8_MMA(1, 0, At, B0); PG8_MMA(1, 1, At, B1); PG8_BAR; PG8_SCHED;
            PG8_LDB(B0, 1, 0); PG8_LDB(B1, 1, 1); PG8_SCHED; PG8_LDA(At, 1, 0); PG8_STAGE(PG8_SA(0, 1), a2 + hstep, voffA);
            PG8_WAIT_V(8); PG8_WAIT_L(0); PG8_BAR; PG8_MMA(0, 0, At, B0); PG8_MMA(0, 1, At, B1); PG8_BAR; PG8_SCHED;
            PG8_LDA(At, 1, 1); PG8_STAGE(PG8_SB(1, 0), b3, voffB); PG8_STAGE(PG8_SB(1, 1), b3 + hstep, voffB); PG8_STAGE(PG8_SA(1, 0), a3, voffA);
            PG8_WAIT_V(8); PG8_WAIT_L(0); PG8_BAR; PG8_MMA(1, 0, At, B0); PG8_MMA(1, 1, At, B1); PG8_BAR; PG8_SCHED;
            } else {
            PG8_LDB(B0, 0, 0); PG8_SCHED; PG8_LDA(At, 0, 0); PG8_STAGE(PG8_SA(1, 1), a1 + hstep, voffA);
            PG8_WAIT_L(8); PG8_BAR; PG8_WAIT_L(0); PG8_MMA(0, 0, At, B0); PG8_BAR; PG8_SCHED;
            PG8_LDB(B1, 0, 1); PG8_STAGE(PG8_SB(0, 0), b2, voffB);
            PG8_BAR; PG8_WAIT_L(0); PG8_MMA(0, 1, At, B1); PG8_BAR;
            PG8_LDA(At, 0, 1); PG8_STAGE(PG8_SA(0, 0), a2, voffA);
            PG8_BAR; PG8_WAIT_L(0); PG8_MMA(1, 0, At, B0); PG8_BAR; PG8_SCHED;
            PG8_STAGE(PG8_SB(0, 1), b2 + hstep, voffB);
            PG8_WAIT_V(6); PG8_BAR; PG8_MMA(1, 1, At, B1); PG8_BAR;
            PG8_LDB(B0, 1, 0); PG8_SCHED; PG8_LDA(At, 1, 0); PG8_STAGE(PG8_SA(0, 1), a2 + hstep, voffA);
            PG8_WAIT_L(8); PG8_BAR; PG8_WAIT_L(0); PG8_MMA(0, 0, At, B0); PG8_BAR; PG8_SCHED;
            PG8_LDB(B1, 1, 1); PG8_STAGE(PG8_SB(1, 0), b3, voffB);
            PG8_BAR; PG8_WAIT_L(0); PG8_MMA(0, 1, At, B1); PG8_BAR;
            PG8_LDA(At, 1, 1); PG8_STAGE(PG8_SA(1, 0), a3, voffA);
            PG8_BAR; PG8_WAIT_L(0); PG8_MMA(1, 0, At, B0); PG8_BAR; PG8_SCHED;
            PG8_STAGE(PG8_SB(1, 1), b3 + hstep, voffB);
            PG8_WAIT_V(6); PG8_BAR; PG8_MMA(1, 1, At, B1); PG8_BAR;
            }
        }
        if constexpr (ALIGN_EPI) { if (wr == 0) PG8_BAR; }
        if constexpr (!Epi::AFTER_DRAIN) { E(acc, cur, wr, wc, fr, fq); S.done(cur); }
        if (!has_next) break;
#pragma unroll
        for (int a = 0; a < 2; ++a)
#pragma unroll
            for (int b = 0; b < 2; ++b)
#pragma unroll
                for (int m = 0; m < 4; ++m)
#pragma unroll
                    for (int n = 0; n < 2; ++n) acc[a][b][m][n] = (f32x4){0.f, 0.f, 0.f, 0.f};
        cur = nxt; cA = nA; cB = nB; ++ui;
        if constexpr (ALIGN_EPI) { if (wr == 1) PG8_BAR; }
    }
    PG8_WAIT_V(0);
    if constexpr (!ALIGN_EPI) { if (wr == 0) PG8_BAR; }
    PG8_BAR;
    if constexpr (Epi::AFTER_DRAIN) { E.fused(acc, cur, wr, wc, fr, fq, lds, wid, lane); S.done(cur); }
#undef PG8_SA
#undef PG8_SB
#undef PG8_STAGE
#undef PG8_LDA
#undef PG8_LDB
#undef PG8_MMA
#undef PG8_WAIT_V
#undef PG8_WAIT_L
#undef PG8_BAR
#undef PG8_SCHED
}
}
#define LAS __attribute__((address_space(3)))
typedef unsigned short bf16;
typedef unsigned u32x4 __attribute__((ext_vector_type(4)));
typedef unsigned u32x2 __attribute__((ext_vector_type(2)));
typedef float f32x4 __attribute__((ext_vector_type(4)));
typedef float f32x16 __attribute__((ext_vector_type(16)));
typedef short bf16x8 __attribute__((ext_vector_type(8)));
typedef short s16x4 __attribute__((ext_vector_type(4)));

constexpr int DM = 1024, NB = 8, SEQ = 4096, CTXL = 256, NL = NB * SEQ, NC = NB * CTXL, MT = NL + NC, DFF = 2816, NMOD = 9 * DM;
constexpr float EPS = 1e-6f;
constexpr float LOG2E = 1.4426950408889634f;
constexpr int NTHREADS = 512;
constexpr int LDS_BYTES = 131072 + 1024;

struct Params {
    const float *x, *c, *ctx, *c_ctx, *ada_w, *ada_b, *norm_g, *ffn_w_in, *ffn_w_out;
    const float *da_w_in, *da_lambda, *da_subln, *da_w_out;
    const float *ga_w_in, *ga_q_norm, *ga_k_norm, *ga_w_out;
    const float *mla_w_in, *mla_q_norm, *mla_kv_norm, *mla_w_uq, *mla_w_ukv, *mla_w_out;
    const float *swa_w_in, *swa_sink, *swa_w_out;
    float* out; unsigned char* ws;
};

constexpr size_t MiB = (size_t)1 << 20;
constexpr size_t WS_BAR = MiB + MiB / 2;
constexpr size_t WS_MOD = 0, WS_PART = 2 * MiB, WS_HC = 24 * MiB;
constexpr size_t WS_FIN = 32 * MiB, FIN_BYTES = 11 * MiB;
constexpr size_t WS_FOUT = 120 * MiB, FOUT_BYTES = 5 * MiB + MiB / 2;
constexpr size_t WS_DA_IN = 164 * MiB, WS_DA_OUT = 170 * MiB, WS_GA_IN = 172 * MiB, WS_GA_OUT = 175 * MiB;
constexpr size_t WS_MLA_IN = 177 * MiB, WS_MLA_UQ = 178 * MiB, WS_MLA_UKV = 179 * MiB, WS_MLA_OUT = 180 * MiB;
constexpr size_t WS_SWA_IN = 182 * MiB, WS_SWA_OUT = 185 * MiB;
constexpr size_t WS_A = 188 * MiB;
constexpr size_t WS_Y = 256 * MiB;
constexpr size_t WS_U = 392 * MiB;
constexpr size_t WS_END = 640 * MiB;
constexpr size_t WS_CIN = WS_Y, WS_AQ = WS_Y + 34 * MiB, WS_AKV = WS_Y + 51 * MiB, WS_MQ = WS_U, WS_MKV = WS_U + 102 * MiB;
constexpr int NKC = 16;

__device__ __forceinline__ float wave_sum(float v) {
#pragma unroll
    for (int o = 1; o < 64; o <<= 1) v += __shfl_xor(v, o);
    return v;
}
__device__ __forceinline__ unsigned pk2(float lo, float hi) { return pg8::cvt_pk_bf16(lo, hi); }
__device__ __forceinline__ float bflo(unsigned w) { return __uint_as_float(w << 16); }
__device__ __forceinline__ float bfhi(unsigned w) { return __uint_as_float(w & 0xffff0000u); }
__device__ __forceinline__ float silu_f(float v) { return v / (1.0f + __expf(-v)); }

__device__ __forceinline__ void transpose_item(const float* __restrict__ W, int N, bf16* WT, int ldk, int k0, int n0, int drow0, LAS float* scr, int lane) {
#pragma unroll 8
    for (int i = 0; i < 32; ++i) { const int kk = 2 * i + (lane >> 5); scr[kk * 33 + (lane & 31)] = W[(size_t)(k0 + kk) * N + n0 + (lane & 31)]; }
    asm volatile("s_waitcnt lgkmcnt(0)" ::: "memory");
    const int c = lane & 7;
#pragma unroll
    for (int j = 0; j < 4; ++j) { const int n = (lane >> 3) + 8 * j; const LAS float* s = scr + (8 * c) * 33 + n;
        u32x4 o; o.x = pk2(s[0 * 33], s[1 * 33]); o.y = pk2(s[2 * 33], s[3 * 33]); o.z = pk2(s[4 * 33], s[5 * 33]); o.w = pk2(s[6 * 33], s[7 * 33]);
        *(u32x4*)(WT + (size_t)(drow0 + n) * ldk + k0 + 8 * c) = o; }
    asm volatile("s_waitcnt lgkmcnt(0)" ::: "memory");
}
__device__ __forceinline__ int swiglu_row(int n0) { return n0 < DFF ? (n0 >> 7) * 256 + (n0 & 127) : ((n0 - DFF) >> 7) * 256 + 128 + ((n0 - DFF) & 127); }

__device__ __forceinline__ void phase0(const Params& p, LAS unsigned char* lds, int G) {
    const int tid = tid_opaque(), lane = tid & 63, wid = tid >> 6;
    unsigned char* ws = p.ws;
    LAS float* sc = (LAS float*)lds;
    for (int i = tid; i < 9 * DM; i += NTHREADS) { const float v = i < 8 * DM ? p.c[i] : p.c_ctx[i - 8 * DM]; sc[i] = silu_f(v); }
    __syncthreads();
    {
        const int gt = bid_opaque() * NTHREADS + tid, GT = G * NTHREADS;
        float* part = (float*)(ws + WS_PART);
        for (int w = gt; w < 4 * NKC * (NMOD / 4); w += GT) {
            const int col4 = w % (NMOD / 4), kc = (w / (NMOD / 4)) % NKC, layer = w / ((NMOD / 4) * NKC);
            const float* wp = p.ada_w + ((size_t)layer * DM + kc * 64) * NMOD + col4 * 4;
            f32x4 acc[9];
#pragma unroll
            for (int r = 0; r < 9; ++r) acc[r] = (f32x4){0.f, 0.f, 0.f, 0.f};
#pragma unroll 4
            for (int k = 0; k < 64; ++k) {
                const f32x4 wv = *(const f32x4*)(wp + (size_t)k * NMOD);
#pragma unroll
                for (int r = 0; r < 9; ++r) { const float s = sc[r * DM + kc * 64 + k]; acc[r] += wv * s; }
            }
#pragma unroll
            for (int r = 0; r < 9; ++r) *(f32x4*)(part + ((size_t)(kc * 4 + layer) * 9 + r) * NMOD + col4 * 4) = acc[r];
        }
    }
    {
        LAS float* scr = (LAS float*)(lds + 40960) + wid * (64 * 33);
        const int gw = bid_opaque() * 8 + wid, NGW = G * 8;
        constexpr int I_FIN = 16 * 176, I_FOUT = 44 * 32, I_SQ = 16 * 32;
        constexpr int I_DA_IN = 16 * 96, I_GA_IN = 16 * 48, I_MLA_IN = 16 * 13, I_MLA_UQ = 4 * 48, I_MLA_UKV = 2 * 64, I_SWA_IN = 16 * 40;
        constexpr int TOTAL = 8 * I_FIN + 8 * I_FOUT + 4 * I_SQ + I_DA_IN + I_GA_IN + I_MLA_IN + I_MLA_UQ + I_MLA_UKV + I_SWA_IN;
        for (int it = gw; it < TOTAL; it += NGW) {
            int r = it;
            if (r < 8 * I_FIN) { const int f = r / I_FIN, rr = r % I_FIN, kb = rr / 176, n0 = (rr % 176) * 32;
                transpose_item(p.ffn_w_in + (size_t)f * DM * 2 * DFF, 2 * DFF, (bf16*)(ws + WS_FIN + f * FIN_BYTES), DM, kb * 64, n0, swiglu_row(n0), scr, lane); continue; }
            r -= 8 * I_FIN;
            if (r < 8 * I_FOUT) { const int f = r / I_FOUT, rr = r % I_FOUT, kb = rr / 32, n0 = (rr % 32) * 32;
                transpose_item(p.ffn_w_out + (size_t)f * DFF * DM, DM, (bf16*)(ws + WS_FOUT + f * FOUT_BYTES), DFF, kb * 64, n0, n0, scr, lane); continue; }
            r -= 8 * I_FOUT;
#define MATX(SRC, K_, N_, DST, LDK) { constexpr int nit_ = ((K_) / 64) * ((N_) / 32); if (r < nit_) { const int kb = r / ((N_) / 32), n0 = (r % ((N_) / 32)) * 32; \
                transpose_item(SRC, N_, (bf16*)(ws + (DST)), LDK, kb * 64, n0, n0, scr, lane); continue; } r -= nit_; }
            MATX(p.da_w_out, 1024, 1024, WS_DA_OUT, 1024)
            MATX(p.ga_w_out, 1024, 1024, WS_GA_OUT, 1024)
            MATX(p.mla_w_out, 1024, 1024, WS_MLA_OUT, 1024)
            MATX(p.swa_w_out, 1024, 1024, WS_SWA_OUT, 1024)
            MATX(p.da_w_in, 1024, 3072, WS_DA_IN, 1024)
            MATX(p.ga_w_in, 1024, 1536, WS_GA_IN, 1024)
            MATX(p.mla_w_in, 1024, 416, WS_MLA_IN, 1024)
            MATX(p.mla_w_uq, 256, 1536, WS_MLA_UQ, 256)
            MATX(p.mla_w_ukv, 128, 2048, WS_MLA_UKV, 128)
            MATX(p.swa_w_in, 1024, 1280, WS_SWA_IN, 1024)
#undef MATX
        }
        const int gt = bid_opaque() * NTHREADS + tid, GT = G * NTHREADS;
        for (int i = gt; i < 96 * 1024 / 8; i += GT) *(u32x4*)((bf16*)(ws + WS_MLA_IN) + (size_t)416 * 1024 + (size_t)i * 8) = (u32x4){0u, 0u, 0u, 0u};
    }
}
__device__ __forceinline__ void phase0b(const Params& p, int G) {
    const int gt = bid_opaque() * NTHREADS + tid_opaque(), GT = G * NTHREADS;
    const float* part = (const float*)(p.ws + WS_PART); float* mod = (float*)(p.ws + WS_MOD);
    for (int o = gt; o < 4 * 9 * NMOD / 4; o += GT) {
        const int col4 = o % (NMOD / 4), lr = o / (NMOD / 4), layer = lr / 9;
        f32x4 a = *(const f32x4*)(p.ada_b + (size_t)layer * NMOD + col4 * 4);
#pragma unroll
        for (int kc = 0; kc < NKC; ++kc) a += *(const f32x4*)(part + ((size_t)(kc * 4 + layer) * 9 + (lr % 9)) * NMOD + col4 * 4);
        *(f32x4*)(mod + (size_t)lr * NMOD + col4 * 4) = a;
    }
}

template <bool INIT, bool RES, bool NEXT>
__device__ __forceinline__ void rowop_rows(const Params& p, int row0, int nrows, int gw, int NGW, float wgt, const float* mod_res, int kgate, const float* g_post,
                                           const float* mod_next, int knext, const float* g_pre) {
    const int lane = tid_opaque() & 63;
    float* hc = (float*)(p.ws + WS_HC); const bf16* Y = (const bf16*)(p.ws + WS_Y); bf16* A = (bf16*)(p.ws + WS_A);
    for (int ri = gw; ri < nrows; ri += NGW) {
        const int row = row0 + ri;
        const bool lat = row < NL;
        const int mr = lat ? (row >> 12) : 8;
        float* hrow = lat ? p.out + (size_t)row * DM : hc + (size_t)(row - NL) * DM;
        f32x4 h[4];
        if (INIT) { const float* xr = lat ? p.x + (size_t)row * DM : p.ctx + (size_t)(row - NL) * DM;
#pragma unroll
            for (int j = 0; j < 4; ++j) h[j] = *(const f32x4*)(xr + (512 * (j >> 1) + 8 * lane + 4 * (j & 1))); }
        else if (lat) {
#pragma unroll
            for (int j = 0; j < 4; ++j) { const u32x2 hw = *(const u32x2*)((const bf16*)hrow + (512 * (j >> 1) + 8 * lane + 4 * (j & 1))); h[j] = (f32x4){bflo(hw.x), bfhi(hw.x), bflo(hw.y), bfhi(hw.y)}; } }
        else {
#pragma unroll
            for (int j = 0; j < 4; ++j) h[j] = *(const f32x4*)(hrow + (512 * (j >> 1) + 8 * lane + 4 * (j & 1))); }
        if (RES) {
            f32x4 y[4]; float ss = 0.f;
#pragma unroll
            for (int j = 0; j < 4; ++j) { const u32x2 yw = *(const u32x2*)(Y + (size_t)row * DM + (512 * (j >> 1) + 8 * lane + 4 * (j & 1))); y[j] = (f32x4){bflo(yw.x), bfhi(yw.x), bflo(yw.y), bfhi(yw.y)}; ss += (y[j].x * y[j].x + y[j].y * y[j].y) + (y[j].z * y[j].z + y[j].w * y[j].w); }
            const float r = wgt * __builtin_amdgcn_rsqf(wave_sum(ss) * (1.0f / DM) + EPS);
            const float* gate = mod_res + (size_t)mr * NMOD + kgate * DM;
#pragma unroll
            for (int j = 0; j < 4; ++j) { const f32x4 gt_ = *(const f32x4*)(gate + (512 * (j >> 1) + 8 * lane + 4 * (j & 1))), gp = *(const f32x4*)(g_post + (512 * (j >> 1) + 8 * lane + 4 * (j & 1))); h[j] += gt_ * (y[j] * r) * gp; }
        }
        if (INIT || RES) {
            if (lat && NEXT) {
#pragma unroll
                for (int j = 0; j < 4; ++j) { u32x2 w; w.x = pk2(h[j].x, h[j].y); w.y = pk2(h[j].z, h[j].w); *(u32x2*)((bf16*)hrow + (512 * (j >> 1) + 8 * lane + 4 * (j & 1))) = w; } }
            else {
#pragma unroll
                for (int j = 0; j < 4; ++j) *(f32x4*)(hrow + (512 * (j >> 1) + 8 * lane + 4 * (j & 1))) = h[j]; } }
        if (NEXT) {
            float ss = 0.f;
#pragma unroll
            for (int j = 0; j < 4; ++j) ss += (h[j].x * h[j].x + h[j].y * h[j].y) + (h[j].z * h[j].z + h[j].w * h[j].w);
            const float r = __builtin_amdgcn_rsqf(wave_sum(ss) * (1.0f / DM) + EPS);
            const float* shift = mod_next + (size_t)mr * NMOD + knext * DM; const float* scale = shift + DM;
#pragma unroll
            for (int j = 0; j < 4; ++j) { const f32x4 sh = *(const f32x4*)(shift + (512 * (j >> 1) + 8 * lane + 4 * (j & 1))), scl = *(const f32x4*)(scale + (512 * (j >> 1) + 8 * lane + 4 * (j & 1))), gp = *(const f32x4*)(g_pre + (512 * (j >> 1) + 8 * lane + 4 * (j & 1)));
                const f32x4 a = (h[j] * r) * gp * (scl + 1.0f) + sh;
                u32x2 w; w.x = pk2(a.x, a.y); w.y = pk2(a.z, a.w); *(u32x2*)(A + (size_t)row * DM + (512 * (j >> 1) + 8 * lane + 4 * (j & 1))) = w; }
        }
    }
}

template <bool INIT, bool RES, bool NEXT>
__device__ __forceinline__ void rowop(const Params& p, int G, int nrows, float wgt, const float* mod_res, int kgate, const float* g_post,
                                      const float* mod_next, int knext, const float* g_pre) {
    rowop_rows<INIT, RES, NEXT>(p, 0, nrows, bid_opaque() * 8 + (tid_opaque() >> 6), G * 8, wgt, mod_res, kgate, g_post, mod_next, knext, g_pre);
}

template <int NAX> __device__ __forceinline__ void rope_cs(int j, int s, float& cs, float& sn) {
    const int f = j % NAX; const float pos = (float)(j < NAX ? (s >> 6) : (s & 63));
    const float freq = __builtin_amdgcn_exp2f(-13.287712379549449f * (float)f / (float)NAX);
    const float ang = pos * freq; cs = __cosf(ang); sn = __sinf(ang);
}
__device__ __forceinline__ unsigned rope_pair(unsigned w, float cs, float sn) { const float x0 = bflo(w), x1 = bfhi(w); return pk2(x0 * cs - x1 * sn, x0 * sn + x1 * cs); }

__device__ __forceinline__ void post_da(const Params& p, int G) {
    const int lane = tid_opaque() & 63, wid = tid_opaque() >> 6, gw = bid_opaque() * 8 + wid, NGW = G * 8;
    bf16* Q = (bf16*)(p.ws + WS_U);
    for (int row = gw; row < NL; row += NGW) {
        float cs, sn; rope_cs<16>(lane & 31, row & 4095, cs, sn);
        unsigned* rp = (unsigned*)(Q + (size_t)row * 3072) + (lane >> 5) * 32 + (lane & 31);
#pragma unroll 4
        for (int it = 0; it < 16; ++it) rp[it * 64] = rope_pair(rp[it * 64], cs, sn);
    }
}
__device__ __forceinline__ void post_swa(const Params& p, int G) {
    const int lane = tid_opaque() & 63, wid = tid_opaque() >> 6, gw = bid_opaque() * 8 + wid, NGW = G * 8;
    bf16* Q = (bf16*)(p.ws + WS_U);
    for (int row = gw; row < NL; row += NGW) {
        float cs, sn; rope_cs<16>(lane & 31, row & 4095, cs, sn);
        unsigned* rp = (unsigned*)(Q + (size_t)row * 1280) + (lane >> 5) * 32 + (lane & 31);
#pragma unroll 3
        for (int it = 0; it < 9; ++it) rp[it * 64] = rope_pair(rp[it * 64], cs, sn);
    }
}
__device__ __forceinline__ void post_ga(const Params& p, int G) {
    const int lane = tid_opaque() & 63, wid = tid_opaque() >> 6, gw = bid_opaque() * 8 + wid, NGW = G * 8;
    bf16* Q = (bf16*)(p.ws + WS_U);
    const float gq0 = p.ga_q_norm[2 * lane], gq1 = p.ga_q_norm[2 * lane + 1], gk0 = p.ga_k_norm[2 * lane], gk1 = p.ga_k_norm[2 * lane + 1];
    for (int row = gw; row < MT; row += NGW) {
        float cs = 1.f, sn = 0.f; if (row < NL) rope_cs<32>(lane, row & 4095, cs, sn);
        unsigned* rp = (unsigned*)(Q + (size_t)row * 1536) + lane;
#pragma unroll
        for (int s = 8; s < 10; ++s) { const unsigned w = rp[s * 64]; float x0 = bflo(w), x1 = bfhi(w);
            const float r = __builtin_amdgcn_rsqf(wave_sum(x0 * x0 + x1 * x1) * (1.0f / 128.0f) + EPS);
            x0 = x0 * r * (s < 8 ? gq0 : gk0); x1 = x1 * r * (s < 8 ? gq1 : gk1);
            rp[s * 64] = pk2(x0 * cs - x1 * sn, x0 * sn + x1 * cs); }
    }
}
__device__ __forceinline__ void post_mla1(const Params& p, int G) {
    const int lane = tid_opaque() & 63, wid = tid_opaque() >> 6, gw = bid_opaque() * 8 + wid, NGW = G * 8;
    bf16* CIN = (bf16*)(p.ws + WS_CIN); bf16* AQ = (bf16*)(p.ws + WS_AQ); bf16* AKV = (bf16*)(p.ws + WS_AKV);
    const f32x4 gq = *(const f32x4*)(p.mla_q_norm + 4 * lane); const float gk0 = p.mla_kv_norm[2 * lane], gk1 = p.mla_kv_norm[2 * lane + 1];
    for (int row = gw; row < MT; row += NGW) {
        const bf16* cr = CIN + (size_t)row * 512;
        const u32x2 wq = *(const u32x2*)(cr + 4 * lane); const unsigned wk = *(const unsigned*)(cr + 256 + 2 * lane);
        const float q0 = bflo(wq.x), q1 = bfhi(wq.x), q2 = bflo(wq.y), q3 = bfhi(wq.y), k0 = bflo(wk), k1 = bfhi(wk);
        const float rq = __builtin_amdgcn_rsqf(wave_sum((q0 * q0 + q1 * q1) + (q2 * q2 + q3 * q3)) * (1.0f / 256.0f) + EPS);
        const float rk = __builtin_amdgcn_rsqf(wave_sum(k0 * k0 + k1 * k1) * (1.0f / 128.0f) + EPS);
        u32x2 oq; oq.x = pk2(q0 * rq * gq.x, q1 * rq * gq.y); oq.y = pk2(q2 * rq * gq.z, q3 * rq * gq.w);
        *(u32x2*)(AQ + (size_t)row * 256 + 4 * lane) = oq;
        *(unsigned*)(AKV + (size_t)row * 128 + 2 * lane) = pk2(k0 * rk * gk0, k1 * rk * gk1);
        if (row < NL && lane < 16) { float cs, sn; rope_cs<8>(lane, row & 4095, cs, sn);
            unsigned* kp = (unsigned*)(CIN + (size_t)row * 512 + 384) + lane; *kp = rope_pair(*kp, cs, sn); }
    }
}
__device__ __forceinline__ void post_mla2(const Params& p, int G) {
    const int lane = tid_opaque() & 63, wid = tid_opaque() >> 6, gw = bid_opaque() * 8 + wid, NGW = G * 8;
    bf16* Q = (bf16*)(p.ws + WS_MQ);
    for (int row = gw; row < NL; row += NGW) {
        float cs, sn; rope_cs<8>(lane & 15, row & 4095, cs, sn);
#pragma unroll
        for (int it = 0; it < 4; ++it) { const int head = it * 4 + (lane >> 4);
            unsigned* qp = (unsigned*)(Q + (size_t)row * 1536 + head * 96 + 64) + (lane & 15); *qp = rope_pair(*qp, cs, sn); }
    }
}
__device__ __forceinline__ void da_combine(const Params& p, int G, float lambda_init) {
    const int lane = tid_opaque() & 63, wid = tid_opaque() >> 6, gw = bid_opaque() * 8 + wid, NGW = G * 8;
    const bf16* T = (const bf16*)(p.ws + WS_Y); bf16* O = (bf16*)(p.ws + WS_A);
    const float* lm = p.da_lambda;
    const float lam = __expf(wave_sum(lm[lane] * lm[64 + lane])) - __expf(wave_sum(lm[128 + lane] * lm[192 + lane])) + lambda_init;
    const int h = lane >> 3, d0 = (lane & 7) * 16;
    float g[16];
#pragma unroll
    for (int e = 0; e < 16; ++e) g[e] = p.da_subln[d0 + e] * (1.0f - lambda_init);
    for (int row = gw; row < MT; row += NGW) {
        const bf16* t1 = T + (size_t)row * 2048 + h * 256 + d0; const bf16* t2 = t1 + 128;
        const u32x4 a0 = *(const u32x4*)t1, a1 = *(const u32x4*)(t1 + 8), b0 = *(const u32x4*)t2, b1 = *(const u32x4*)(t2 + 8);
        float o[16];
#pragma unroll
        for (int e = 0; e < 4; ++e) { o[2 * e] = bflo(a0[e]) - lam * bflo(b0[e]); o[2 * e + 1] = bfhi(a0[e]) - lam * bfhi(b0[e]);
                                      o[8 + 2 * e] = bflo(a1[e]) - lam * bflo(b1[e]); o[8 + 2 * e + 1] = bfhi(a1[e]) - lam * bfhi(b1[e]); }
        float ss = 0.f;
#pragma unroll
        for (int e = 0; e < 16; ++e) ss += o[e] * o[e];
        ss += __shfl_xor(ss, 1); ss += __shfl_xor(ss, 2); ss += __shfl_xor(ss, 4);
        const float r = __builtin_amdgcn_rsqf(ss * (1.0f / 128.0f) + EPS);
        u32x4 w0, w1;
#pragma unroll
        for (int e = 0; e < 4; ++e) { w0[e] = pk2(o[2 * e] * r * g[2 * e], o[2 * e + 1] * r * g[2 * e + 1]); w1[e] = pk2(o[8 + 2 * e] * r * g[8 + 2 * e], o[8 + 2 * e + 1] * r * g[8 + 2 * e + 1]); }
        bf16* op = O + (size_t)row * DM + h * 128 + d0; *(u32x4*)op = w0; *(u32x4*)(op + 8) = w1;
    }
}

struct AttnDesc {
    const bf16 *Q, *K, *K2, *V; bf16* O; int ldq, ldk, ldk2, ldv, ldo;
    int nh, q_mul, k_off, k_div, k_mul, k2_off, v_off, v_div, v_mul, o_mul; float scale; const float* sink;
    bf16* O2; const float* aux; const float* lam; float lam_init;
};
__device__ __forceinline__ s16x4 vtr(const LAS unsigned char* ptr) { return __builtin_bit_cast(s16x4, __builtin_amdgcn_ds_read_tr16_b64_v4i16((LAS s16x4*)ptr)); }
typedef __bf16 bf16x2_t __attribute__((ext_vector_type(2))); typedef float f32x2_t __attribute__((ext_vector_type(2)));
__device__ __forceinline__ unsigned cvtpk(float lo, float hi) { f32x2_t v = {lo, hi}; bf16x2_t b = __builtin_convertvector(v, bf16x2_t); return __builtin_bit_cast(unsigned, b); }

__device__ __forceinline__ float swapmax(float v) { auto rr = __builtin_amdgcn_permlane32_swap(__float_as_uint(v), __float_as_uint(v), false, false); return fmaxf(__uint_as_float(rr[0]), __uint_as_float(rr[1])); }
__device__ __forceinline__ float swapsum(float v) { auto rr = __builtin_amdgcn_permlane32_swap(__float_as_uint(v), __float_as_uint(v), false, false); return __uint_as_float(rr[0]) + __uint_as_float(rr[1]); }
#define SBAR() __builtin_amdgcn_sched_barrier(0)
#ifndef ATT_DSMASK
#define ATT_DSMASK 0x00F
#endif
#define ATT_DSFENCE() __builtin_amdgcn_sched_barrier(ATT_DSMASK)
template <int DQK, int DK1, int DV, bool SWA, bool DIFF = false>
__device__ __forceinline__ void attn_phase(LAS unsigned char* lds, const AttnDesc d, bool with_ctx, int G) {
    constexpr int KP = DQK * 2 + 16, VP = (DV == 128) ? 320 : 192, KBUF = 64 * KP, VBUF = 64 * VP, BUFB = KBUF + VBUF;
    constexpr int NS = DQK / 16, ND = DV / 32, KCH = DQK / 8, VCH = DV / 8, NKCH = 64 * KCH, NVCH = 64 * VCH, KI = (NKCH + 511) / 512, VI = (NVCH + 511) / 512;
    static_assert(3 * BUFB <= 131072, "attention ring fits the LDS region");
    constexpr bool SD2 = !(DQK == 128 && DV == 128) && !DIFF;
#ifndef ATT_SGB
#define ATT_SGB true
#endif
    constexpr bool SGB = ATT_SGB; constexpr int SGB_TQ = (16 + 2 * NS - 1) / (2 * NS), SGB_VQ = (48 + 2 * NS - 1) / (2 * NS), SGB_VP = (52 + 4 * ND - 1) / (4 * ND);
    constexpr bool QPREP = (DQK == 128 && DV == 128);
    constexpr bool SEQF = (DQK == 128 && DV == 128);
    const int tid = tid_opaque(), lane = tid & 63, wid = __builtin_amdgcn_readfirstlane(tid >> 6), r32 = lane & 31, hi = lane >> 5;
    const float C = d.scale * LOG2E; constexpr float THRS = 8.0f * LOG2E;
    const int n_lat = NB * d.nh * 16, n_units = n_lat + (with_ctx ? NB * d.nh : 0);
    const int bid_ = bid_opaque(), vcu = (G % 8 == 0) ? (bid_ % 8) * (G / 8) + bid_ / 8 : bid_;
    for (int u = vcu; u < n_units; u += G) {
        int b, head, qb; bool isctx;
        if (u < n_lat) { qb = u & 15; head = (u >> 4) % d.nh; b = (u >> 4) / d.nh; isctx = false; }
        else { const int v = u - n_lat; head = v % d.nh; b = v / d.nh; qb = 0; isctx = true; }
        for (int sub = 0; sub < (DIFF ? 2 : 1); ++sub) {
        const int he = DIFF ? head * 2 + sub : head;
        const int qrow_base = (isctx ? NL + b * CTXL : b * SEQ + qb * 256) + wid * 32;
        const int kcol = d.k_off + (he / d.k_div) * d.k_mul, vcol = d.v_off + (he / d.v_div) * d.v_mul;
        int lat_lo = 0, nlt = isctx ? 0 : 64;
        if (SWA) { const int q0 = qb * 256; lat_lo = q0 - 128 < 0 ? 0 : q0 - 128; const int lat_hi = q0 + 384 > SEQ ? SEQ : q0 + 384; nlt = (lat_hi - lat_lo) >> 6; }
        const int NT = 4 + nlt;
        const int ctx_row0 = NL + b * CTXL, lat_row0 = b * SEQ + lat_lo;
        const int qpos = qb * 256 + wid * 32 + r32;
        bf16x8 qf[NS];
        { int lq_ = lane; asm volatile("" : "+v"(lq_)); const bf16* qp = d.Q + (size_t)(qrow_base + (lq_ & 31)) * d.ldq + he * d.q_mul + (lq_ >> 5) * 8;
#pragma unroll
          for (int s = 0; s < NS; ++s) qf[s] = *(const bf16x8*)(qp + s * 16); }
        if (QPREP) {
            float ssq = 0.f;
#pragma unroll
            for (int s = 0; s < NS; ++s)
#pragma unroll
                for (int e = 0; e < 8; ++e) { const float v = __uint_as_float((unsigned)(unsigned short)qf[s][e] << 16); ssq += v * v; }
            ssq = swapsum(ssq);
            const float rq = __builtin_amdgcn_rsqf(ssq * (1.0f / 128.0f) + EPS);
            int lh_ = lane; asm volatile("" : "+v"(lh_)); const int hq = lh_ >> 5, rq32 = lh_ & 31;
            const int sp_ = (qrow_base + rq32) & 4095; const float prow = (float)(sp_ >> 6), pcol = (float)(sp_ & 63);
#pragma unroll
            for (int s = 0; s < NS; ++s) {
                const f32x4 g0 = *(const f32x4*)(d.aux + s * 16 + hq * 8), g1 = *(const f32x4*)(d.aux + s * 16 + hq * 8 + 4);
                float x[8];
#pragma unroll
                for (int e = 0; e < 8; ++e) x[e] = __uint_as_float((unsigned)(unsigned short)qf[s][e] << 16) * rq * (e < 4 ? g0[e] : g1[e - 4]);
                if (!isctx) {
#pragma unroll
                    for (int pr = 0; pr < 4; ++pr) { const int j = s * 8 + hq * 4 + pr;
                        const float freq = __builtin_amdgcn_exp2f(-13.287712379549449f * (float)(j & 31) * (1.0f / 32.0f)); const float ang = (s < 4 ? prow : pcol) * freq;
                        const float cs = __cosf(ang), sn = __sinf(ang), a = x[2 * pr], b2 = x[2 * pr + 1]; x[2 * pr] = a * cs - b2 * sn; x[2 * pr + 1] = a * sn + b2 * cs; } }
                u32x4 w; w.x = cvtpk(x[0], x[1]); w.y = cvtpk(x[2], x[3]); w.z = cvtpk(x[4], x[5]); w.w = cvtpk(x[6], x[7]); qf[s] = __builtin_bit_cast(bf16x8, w);
            }
        }
        u32x4 kreg0[KI], vreg0[VI], kreg1[KI], vreg1[VI];
    constexpr bool K2S = (DK1 != DQK); constexpr int KCHA = K2S ? DK1 / 8 : KCH, KCHB = K2S ? (DQK - DK1) / 8 : 1, KRP = 512 / KCHA, VRP = 512 / VCH;
    static_assert(512 % KCHA == 0 && 512 % VCH == 0 && (!K2S || (64 * KCHA == 512 && 64 * KCHB <= 512 && KI == 2)), "staging map");
    constexpr bool HOIST = true;
    unsigned h_vgo = 0, h_kgo = 0, h_kgoB = 0, h_vlo = 0, h_klo = 0, h_kloB = 0;
    if (HOIST) { h_vgo = (unsigned)((tid / VCH) * d.ldv + (tid % VCH) * 8) * 2u; h_kgo = (unsigned)((tid / KCHA) * d.ldk + (tid % KCHA) * 8) * 2u; h_kgoB = K2S ? (unsigned)((tid / KCHB) * d.ldk2 + (tid % KCHB) * 8) * 2u : 0u;
        h_vlo = (unsigned)((tid / VCH) * VP + (tid % VCH) * 16); h_klo = (unsigned)((tid / KCHA) * KP + (tid % KCHA) * 16); h_kloB = K2S ? (unsigned)((tid / KCHB) * KP + DK1 * 2 + (tid % KCHB) * 16) : 0u; }
#define ATT_GOFF() unsigned vgo, kgo, kgoB; if (HOIST) { vgo = h_vgo; kgo = h_kgo; kgoB = h_kgoB; } else { int t2_ = tid; asm volatile("" : "+v"(t2_)); \
            vgo = (unsigned)((t2_ / VCH) * d.ldv + (t2_ % VCH) * 8) * 2u; kgo = (unsigned)((t2_ / KCHA) * d.ldk + (t2_ % KCHA) * 8) * 2u; kgoB = K2S ? (unsigned)((t2_ / KCHB) * d.ldk2 + (t2_ % KCHB) * 8) * 2u : 0u; } (void)kgoB
#define ATT_LOFF() unsigned vlo, klo, kloB; if (HOIST) { vlo = h_vlo; klo = h_klo; kloB = h_kloB; } else { int t3_ = tid; asm volatile("" : "+v"(t3_)); \
            vlo = (unsigned)((t3_ / VCH) * VP + (t3_ % VCH) * 16); klo = (unsigned)((t3_ / KCHA) * KP + (t3_ % KCHA) * 16); kloB = K2S ? (unsigned)((t3_ / KCHB) * KP + DK1 * 2 + (t3_ % KCHB) * 16) : 0u; } (void)kloB
#define ATT_LOAD(t_, kreg, vreg) ATT_LOADX(t_, kreg, vreg, ctx_row0, lat_row0, kcol, vcol)
#define ATT_LOADX(t_, kreg, vreg, ctx_row0, lat_row0, kcol, vcol) do { ATT_GOFF(); const int krow0_ = (t_) < 4 ? ctx_row0 + (t_) * 64 : lat_row0 + ((t_) - 4) * 64; \
            if (!K2S) { _Pragma("unroll") for (int i_ = 0; i_ < KI; ++i_) { const char* kb_ = (const char*)(d.K + (size_t)(krow0_ + i_ * KRP) * d.ldk + kcol); kreg[i_] = *(const u32x4*)(kb_ + kgo); } } \
            else { kreg[0] = *(const u32x4*)((const char*)(d.K + (size_t)krow0_ * d.ldk + kcol) + kgo); \
                   if (tid < 64 * KCHB) kreg[1] = *(const u32x4*)((const char*)(d.K2 + (size_t)krow0_ * d.ldk2 + d.k2_off) + kgoB); } \
            _Pragma("unroll") for (int i_ = 0; i_ < VI; ++i_) { const char* vb_ = (const char*)(d.V + (size_t)(krow0_ + i_ * VRP) * d.ldv + vcol); vreg[i_] = *(const u32x4*)(vb_ + vgo); } } while (0)
#define ATT_STORE(boff_, kreg, vreg) do { ATT_LOFF(); LAS unsigned char* kb_ = lds + (boff_); \
            if (!K2S) { _Pragma("unroll") for (int i_ = 0; i_ < KI; ++i_) *(LAS u32x4*)(kb_ + i_ * KRP * KP + klo) = kreg[i_]; } \
            else { *(LAS u32x4*)(kb_ + klo) = kreg[0]; if (tid < 64 * KCHB) *(LAS u32x4*)(kb_ + kloB) = kreg[1]; } \
            _Pragma("unroll") for (int i_ = 0; i_ < VI; ++i_) *(LAS u32x4*)(kb_ + KBUF + i_ * VRP * VP + vlo) = vreg[i_]; } while (0)
#define ATT_QKT(P0, P1, boff_) do { const LAS unsigned char* kb_ = lds + (boff_) + r32 * KP + hi * 16; P0 = f32x16{}; P1 = f32x16{}; __builtin_amdgcn_s_setprio(1); \
            _Pragma("unroll") for (int s_ = 0; s_ < NS; ++s_) { const bf16x8 k0_ = *(const LAS bf16x8*)(kb_ + s_ * 32), k1_ = *(const LAS bf16x8*)(kb_ + 32 * KP + s_ * 32); \
                P0 = __builtin_amdgcn_mfma_f32_32x32x16_bf16(k0_, qf[s_], P0, 0, 0, 0); P1 = __builtin_amdgcn_mfma_f32_32x32x16_bf16(k1_, qf[s_], P1, 0, 0, 0); if (s_ & 1) ATT_DSFENCE(); } __builtin_amdgcn_s_setprio(0); } while (0)
#define ATT_MASK(P0, P1, t_) do { \
            if (SWA && (t_) >= 4) { const int kt_ = lat_lo + ((t_) - 4) * 64, qw_ = qb * 256 + wid * 32;     \
                if (kt_ < qw_ - 97 || kt_ > qw_ + 65) {                                                      \
                    if (kt_ > qw_ + 159 || kt_ + 63 < qw_ - 128) { _Pragma("unroll") for (int i_ = 0; i_ < 16; ++i_) { P0[i_] = -1e30f; P1[i_] = -1e30f; } }     \
                    else { const int kp0_ = kt_ + 4 * hi; \
                        _Pragma("unroll") for (int i_ = 0; i_ < 16; ++i_) { const int kp_ = kp0_ + (i_ & 3) + 8 * (i_ >> 2); int dd_ = qpos - kp_; dd_ = dd_ < 0 ? -dd_ : dd_; if (dd_ > 128) P0[i_] = -1e30f; \
                            int d2_ = qpos - kp_ - 32; d2_ = d2_ < 0 ? -d2_ : d2_; if (d2_ > 128) P1[i_] = -1e30f; } } } } } while (0)
          \
#define ATT_PARTIAL0(P0, P1, AL) do { \
            float pm_ = fmaxf(P0[0], P1[0]); \
            _Pragma("unroll") for (int i_ = 1; i_ < 16; ++i_) pm_ = fmaxf(pm_, fmaxf(P0[i_], P1[i_])); \
            pm_ = swapmax(pm_); ms = pm_ * C; AL = 0.f; const float mc_ = -ms; \
            _Pragma("unroll") for (int i_ = 0; i_ < 16; ++i_) { P0[i_] = fmaf(P0[i_], C, mc_); P1[i_] = fmaf(P1[i_], C, mc_); } \
            _Pragma("unroll") for (int i_ = 0; i_ < 16; ++i_) P0[i_] = __builtin_amdgcn_exp2f(P0[i_]); } while (0)
          \
#define ATT_PARTIAL(P0, P1, t_, AL) do { ATT_MASK(P0, P1, t_); \
            const float mc_ = -ms; \
            _Pragma("unroll") for (int i_ = 0; i_ < 16; ++i_) { P0[i_] = fmaf(P0[i_], C, mc_); P1[i_] = fmaf(P1[i_], C, mc_); } \
            float pa_ = fmaxf(fmaxf(P0[0], P1[0]), P0[1]), pb_ = fmaxf(fmaxf(P1[1], P0[2]), P1[2]); \
            _Pragma("unroll") for (int i_ = 3; i_ < 15; i_ += 2) { pa_ = fmaxf(fmaxf(pa_, P0[i_]), P1[i_]); pb_ = fmaxf(fmaxf(pb_, P0[i_ + 1]), P1[i_ + 1]); } \
            float pm_ = fmaxf(fmaxf(pa_, P0[15]), fmaxf(pb_, P1[15])); \
            pm_ = swapmax(pm_); if (SGB) ATT_SGB_PP(); \
            if (__builtin_expect(__all(pm_ <= THRS), 1)) { AL = 1.f; } \
            else { const float dl_ = fmaxf(pm_, 0.f); ms += dl_; AL = __builtin_amdgcn_exp2f(-dl_); \
                _Pragma("unroll") for (int i_ = 0; i_ < 16; ++i_) { P0[i_] -= dl_; P1[i_] -= dl_; } } \
            _Pragma("unroll") for (int i_ = 0; i_ < 16; ++i_) P0[i_] = __builtin_amdgcn_exp2f(P0[i_]); } while (0)
#define ATT_FINISH(P0, P1, AL) do { \
            _Pragma("unroll") for (int i_ = 0; i_ < 16; ++i_) P1[i_] = __builtin_amdgcn_exp2f(P1[i_]); \
            float ps_ = 0.f; \
            _Pragma("unroll") for (int i_ = 0; i_ < 16; ++i_) ps_ += P0[i_] + P1[i_]; \
            l = l * AL + ps_; u32x4 w_; \
            w_.x = cvtpk(P0[0], P0[1]); w_.y = cvtpk(P0[2], P0[3]); w_.z = cvtpk(P0[4], P0[5]); w_.w = cvtpk(P0[6], P0[7]); pf[0] = __builtin_bit_cast(bf16x8, w_); \
            w_.x = cvtpk(P0[8], P0[9]); w_.y = cvtpk(P0[10], P0[11]); w_.z = cvtpk(P0[12], P0[13]); w_.w = cvtpk(P0[14], P0[15]); pf[1] = __builtin_bit_cast(bf16x8, w_); \
            w_.x = cvtpk(P1[0], P1[1]); w_.y = cvtpk(P1[2], P1[3]); w_.z = cvtpk(P1[4], P1[5]); w_.w = cvtpk(P1[6], P1[7]); pf[2] = __builtin_bit_cast(bf16x8, w_); \
            w_.x = cvtpk(P1[8], P1[9]); w_.y = cvtpk(P1[10], P1[11]); w_.z = cvtpk(P1[12], P1[13]); w_.w = cvtpk(P1[14], P1[15]); pf[3] = __builtin_bit_cast(bf16x8, w_); } while (0)
#define ATT_PV(boff_) do { __builtin_amdgcn_s_setprio(1); const LAS unsigned char* vb_ = lds + (boff_) + KBUF + (4 * hi + ((lane & 15) >> 2)) * VP + (16 * ((lane >> 4) & 1) + 4 * (lane & 3)) * 2; \
            _Pragma("unroll") for (int db_ = 0; db_ < ND; ++db_) _Pragma("unroll") for (int ks_ = 0; ks_ < 4; ++ks_) { \
                const s16x4 lo_ = vtr(vb_ + (16 * ks_) * VP + db_ * 64), up_ = vtr(vb_ + (16 * ks_ + 8) * VP + db_ * 64); \
                const bf16x8 vf_ = (bf16x8){lo_[0], lo_[1], lo_[2], lo_[3], up_[0], up_[1], up_[2], up_[3]}; \
                o[db_] = __builtin_amdgcn_mfma_f32_32x32x16_bf16(vf_, pf[ks_], o[db_], 0, 0, 0); if (ks_ & 1) ATT_DSFENCE(); } __builtin_amdgcn_s_setprio(0); } while (0)
#define ATT_SGB_QF() do { _Pragma("unroll") for (int g_ = 0; g_ < 2 * NS; ++g_) { __builtin_amdgcn_sched_group_barrier(0x008, 1, 0); __builtin_amdgcn_sched_group_barrier(0x100, 1, 0); \
            __builtin_amdgcn_sched_group_barrier(0x400, SGB_TQ, 0); __builtin_amdgcn_sched_group_barrier(0x002, SGB_VQ, 0); } } while (0)
#define ATT_SGB_PP() do { _Pragma("unroll") for (int g_ = 0; g_ < 4 * ND; ++g_) { __builtin_amdgcn_sched_group_barrier(0x008, 1, 0); __builtin_amdgcn_sched_group_barrier(0x100, 2, 0); \
            __builtin_amdgcn_sched_group_barrier(0x002, SGB_VP, 0); } } while (0)
#define ATT_OUT(j_) (SWA && (j_) >= 4 && ((lat_lo + ((j_) - 4) * 64) > (qb * 256 + wid * 32) + 159 || (lat_lo + ((j_) - 4) * 64) + 63 < (qb * 256 + wid * 32) - 128))
#define ATT_STEP(C0, C1, ALC, SKC, N0, N1, ALN, SKN, j_, KL, VL, KS, VS) do { SBAR(); if (SD2) { if ((j_) + 2 < NT) ATT_LOAD((j_) + 2, KL, VL); } else { if ((j_) + 1 < NT) ATT_LOAD((j_) + 1, kreg0, vreg0); } SBAR(); \
            SKN = ATT_OUT(j_); \
            if (SEQF) { if (!SKC) ATT_FINISH(C0, C1, ALC); SBAR(); if (!SKN) ATT_QKT(N0, N1, bo_cur); } else { if (!SKN) ATT_QKT(N0, N1, bo_cur); if (!SKC) ATT_FINISH(C0, C1, ALC); if (SGB) ATT_SGB_QF(); } SBAR(); \
            if (!SKC) ATT_PV(bo_prev); if (!SKN) ATT_PARTIAL(N0, N1, j_, ALN); else ALN = 1.f; \
            if ((j_) + 1 < NT) { if (SD2) ATT_STORE(bo_next, KS, VS); else ATT_STORE(bo_next, kreg0, vreg0); } \
            if (__any(ALN < 1.f)) { _Pragma("unroll") for (int i_ = 0; i_ < ND; ++i_) o[i_] *= ALN; } \
            __syncthreads(); { const int t_ = bo_prev; bo_prev = bo_cur; bo_cur = bo_next; bo_next = t_; } } while (0)
        float ms = 0.f, l = 0.f; bool skA = false, skB = false;
        f32x16 o[ND];
#pragma unroll
        for (int i = 0; i < ND; ++i) o[i] = f32x16{};
        f32x16 pA0, pA1, pB0, pB1; float alA = 1.f, alB = 1.f; bf16x8 pf[4];
        int bo_prev = 0, bo_cur = BUFB, bo_next = 2 * BUFB;
        ATT_LOAD(0, kreg0, vreg0); ATT_STORE(0, kreg0, vreg0);
        __syncthreads();
        ATT_QKT(pA0, pA1, 0); ATT_PARTIAL0(pA0, pA1, alA);
        if (SD2) { ATT_LOAD(1, kreg1, vreg1); ATT_STORE(BUFB, kreg1, vreg1); } else { ATT_LOAD(1, kreg0, vreg0); ATT_STORE(BUFB, kreg0, vreg0); }
        if (SD2) ATT_LOAD(2, kreg0, vreg0);
        __syncthreads();
        for (int j = 1; j + 1 < NT; j += 2) {
            ATT_STEP(pA0, pA1, alA, skA, pB0, pB1, alB, skB, j, kreg1, vreg1, kreg0, vreg0);
            ATT_STEP(pB0, pB1, alB, skB, pA0, pA1, alA, skA, j + 1, kreg0, vreg0, kreg1, vreg1);
        }
        ATT_STEP(pA0, pA1, alA, skA, pB0, pB1, alB, skB, NT - 1, kreg1, vreg1, kreg0, vreg0);
        if (!skB) { ATT_FINISH(pB0, pB1, alB); SBAR();
        ATT_PV(bo_prev); }
#undef ATT_LOAD
#undef ATT_STORE
#undef ATT_QKT
#undef ATT_PARTIAL
#undef ATT_PARTIAL0
#undef ATT_MASK
#undef ATT_FINISH
#undef ATT_PV
#undef ATT_STEP
#undef ATT_OUT
        l = swapsum(l);
        if (SWA) l += __builtin_amdgcn_exp2f(d.sink[head] * LOG2E - ms);
        const float inv = __builtin_amdgcn_rcpf(l);
        int lo_ = lane; asm volatile("" : "+v"(lo_));
        bf16* op = d.O + (size_t)(qrow_base + (lo_ & 31)) * d.ldo + he * d.o_mul + 4 * (lo_ >> 5);
        if (!DIFF || sub == 0) {
            bf16* opw = op + 4 * (lo_ >> 5);
#pragma unroll
            for (int db = 0; db < ND; ++db)
#pragma unroll
                for (int g = 0; g < 4; g += 2) {
                    const unsigned ax = cvtpk(o[db][4 * g] * inv, o[db][4 * g + 1] * inv), ay = cvtpk(o[db][4 * g + 2] * inv, o[db][4 * g + 3] * inv);
                    const unsigned bx = cvtpk(o[db][4 * g + 4] * inv, o[db][4 * g + 5] * inv), by = cvtpk(o[db][4 * g + 6] * inv, o[db][4 * g + 7] * inv);
                    const auto r0 = __builtin_amdgcn_permlane32_swap(ax, bx, false, false); const auto r1 = __builtin_amdgcn_permlane32_swap(ay, by, false, false);
                    u32x4 w; w.x = r0[0]; w.y = r1[0]; w.z = r0[1]; w.w = r1[1];
                    *(u32x4*)(opw + db * 32 + 8 * g) = w; }
        } else {
            const float* lm = d.lam;
            const float lamv = __expf(wave_sum(lm[lo_] * lm[64 + lo_])) - __expf(wave_sum(lm[128 + lo_] * lm[192 + lo_])) + d.lam_init;
            const bf16* tp = op - d.o_mul; float ss = 0.f;
#pragma unroll
            for (int db = 0; db < ND; ++db)
#pragma unroll
                for (int g = 0; g < 4; ++g) { const u32x2 w = *(const u32x2*)(tp + db * 32 + 8 * g);
                    const float v0 = bflo(w.x) - lamv * (o[db][4 * g] * inv), v1 = bfhi(w.x) - lamv * (o[db][4 * g + 1] * inv), v2 = bflo(w.y) - lamv * (o[db][4 * g + 2] * inv), v3 = bfhi(w.y) - lamv * (o[db][4 * g + 3] * inv);
                    o[db][4 * g] = v0; o[db][4 * g + 1] = v1; o[db][4 * g + 2] = v2; o[db][4 * g + 3] = v3; ss += (v0 * v0 + v1 * v1) + (v2 * v2 + v3 * v3); }
            ss = swapsum(ss);
            const float rn = __builtin_amdgcn_rsqf(ss * (1.0f / 128.0f) + EPS) * (1.0f - d.lam_init);
            bf16* op2 = d.O2 + (size_t)(qrow_base + (lo_ & 31)) * DM + head * 128 + 4 * (lo_ >> 5);
            bf16* op2w = op2 + 4 * (lo_ >> 5);
#pragma unroll
            for (int db = 0; db < ND; ++db)
#pragma unroll
                for (int g = 0; g < 4; g += 2) { const f32x4 ga = *(const f32x4*)(d.aux + db * 32 + 8 * g + 4 * (lo_ >> 5)), gb = *(const f32x4*)(d.aux + db * 32 + 8 * g + 8 + 4 * (lo_ >> 5));
                    const unsigned ax = cvtpk(o[db][4 * g] * rn * ga.x, o[db][4 * g + 1] * rn * ga.y), ay = cvtpk(o[db][4 * g + 2] * rn * ga.z, o[db][4 * g + 3] * rn * ga.w);
                    const unsigned bx = cvtpk(o[db][4 * g + 4] * rn * gb.x, o[db][4 * g + 5] * rn * gb.y), by = cvtpk(o[db][4 * g + 6] * rn * gb.z, o[db][4 * g + 7] * rn * gb.w);
                    const auto r0 = __builtin_amdgcn_permlane32_swap(ax, bx, false, false); const auto r1 = __builtin_amdgcn_permlane32_swap(ay, by, false, false);
                    u32x4 w; w.x = r0[0]; w.y = r1[0]; w.z = r0[1]; w.w = r1[1];
                    *(u32x4*)(op2w + db * 32 + 8 * g) = w; }
        }
        asm volatile("s_waitcnt lgkmcnt(0)\n\ts_barrier" ::: "memory");
        }
    }
}

typedef __attribute__((address_space(1))) unsigned gu32;
#define XB_TMO      128
#define XB_XCNT(j)  (256  + 64 * (j))
#define XB_XSUB(j)  (1280 + 64 * (j))
#define XB_XGEN(j)  (2304 + 64 * (j))
#define XB_TOP      3328
#define XB_TOPGEN   3392
#define XCD_BAR_WORDS 3456
#define XB_SPIN_CAP (1u << 18)

__device__ __forceinline__ unsigned xb_ld(unsigned* p)              { return __hip_atomic_load(p, __ATOMIC_RELAXED, __HIP_MEMORY_SCOPE_AGENT); }
__device__ __forceinline__ unsigned xb_add(unsigned* p, unsigned v) { return __hip_atomic_fetch_add(p, v, __ATOMIC_RELAXED, __HIP_MEMORY_SCOPE_AGENT); }
__device__ __forceinline__ unsigned xb_xcc_id() { return (unsigned)__builtin_amdgcn_s_getreg((3 << 11) | 20) & 0xFu; }
#define XB_SPIN(cond, bar) do { unsigned _sp = 0; while (cond) { __builtin_amdgcn_s_sleep(1); \
    if ((++_sp & 255u) == 0u) { if (xb_ld(&(bar)[XB_TMO])) break; if (_sp > XB_SPIN_CAP) { atomicAdd(&(bar)[XB_TMO], 1u); break; } } } } while (0)

struct XcdBarrier {
    unsigned* bar; unsigned x;
    volatile LAS unsigned* st;
};

__device__ __forceinline__ XcdBarrier xcd_barrier_post(unsigned* bar, volatile LAS unsigned* st) {
    XcdBarrier b; b.bar = bar; b.x = xb_xcc_id(); b.st = st;
    if (threadIdx.x == 0) (void)xb_add(&bar[XB_XCNT(b.x)], 1u);
    return b;
}
__device__ __forceinline__ void xcd_barrier_complete(unsigned* bar, unsigned x, unsigned& nloc, unsigned& nx) {
    const unsigned G = gridDim.x * gridDim.y * gridDim.z;
    unsigned sum, cnt, mine, sp = 0u;
    for (;;) {
        sum = 0u; cnt = 0u; mine = 0u;
#pragma unroll
        for (unsigned j = 0; j < 16; ++j) { const unsigned c = xb_ld(&bar[XB_XCNT(j)]); sum += c; cnt += (c > 0u) ? 1u : 0u; mine = (j == x) ? c : mine; }
        if (sum == G) break;
        __builtin_amdgcn_s_sleep(1);
        if ((++sp & 255u) == 0u) { if (xb_ld(&bar[XB_TMO])) break; if (sp > XB_SPIN_CAP) { atomicAdd(&bar[XB_TMO], 1u); break; } }
    }
    nloc = mine > 0u ? mine : 1u; nx = cnt > 0u ? cnt : 1u;
}

__device__ __forceinline__ void xcd_barrier(const XcdBarrier& b) {
    asm volatile("s_waitcnt vmcnt(0)" ::: "memory");
    __syncthreads();
    if (threadIdx.x == 0) {
        unsigned* bar = b.bar;
        __builtin_amdgcn_s_waitcnt(0);
        unsigned nloc = b.st[0], nx = b.st[1];
        if (nloc == 0u) { xcd_barrier_complete(bar, b.x, nloc, nx); b.st[0] = nloc; b.st[1] = nx; }
        const unsigned old = xb_add(&bar[XB_XSUB(b.x)], 1u);
        const unsigned gen = old / nloc;
        if (old + 1u == (gen + 1u) * nloc) {
            __builtin_amdgcn_fence(__ATOMIC_RELEASE, "agent");
            asm volatile("s_waitcnt vmcnt(0)" ::: "memory");
            const unsigned og = xb_add(&bar[XB_TOP], 1u);
            const unsigned tg = og / nx;
            if (og + 1u == (tg + 1u) * nx) xb_add(&bar[XB_TOPGEN], 1u);
            else XB_SPIN(xb_ld(&bar[XB_TOPGEN]) == tg, bar);
            __builtin_amdgcn_fence(__ATOMIC_ACQUIRE, "agent");
            xb_add(&bar[XB_XGEN(b.x)], 1u);
            asm volatile("s_waitcnt vmcnt(0)" ::: "memory");
        } else {
            XB_SPIN(xb_ld(&bar[XB_XGEN(b.x)]) == gen, bar);
            __builtin_amdgcn_fence(__ATOMIC_ACQUIRE, "agent");
            asm volatile("s_waitcnt vmcnt(0)" ::: "memory");
        }
    }
    __syncthreads();
}

#ifndef GALIGN
#define GALIGN true
#endif
#ifndef GSP2
#define GSP2 true
#endif
template <class T> __device__ __forceinline__ T* uptr(T* q) {
    const unsigned long long v = (unsigned long long)q; const unsigned lo = __builtin_amdgcn_readfirstlane((unsigned)v), hi = __builtin_amdgcn_readfirstlane((unsigned)(v >> 32));
    return (T*)(__attribute__((address_space(1))) T*)(((unsigned long long)hi << 32) | lo); }
#define LOADP() Params p; { auto q_ = __builtin_amdgcn_kernarg_segment_ptr(); asm volatile("" : "+s"(q_)); __builtin_memcpy(&p, (const void*)q_, sizeof(Params)); } \
    unsigned char* const ws = uptr(p.ws); const int G = gridDim.x; (void)ws; (void)G
#define GSYNC_CG() cg::this_grid().sync()
#define GSYNC() do { LOADP(); XcdBarrier b_; b_.bar = (unsigned*)(ws + WS_BAR); b_.x = xb_xcc_id(); b_.st = (volatile LAS unsigned*)(lds + 131072 + 32); xcd_barrier(b_); } while (0)
__global__ void __launch_bounds__(NTHREADS, 2) fwd_megakernel(Params p_unused) {
    extern __shared__ __attribute__((aligned(16))) unsigned char lds_raw[];
    LAS unsigned char* lds = (LAS unsigned char*)lds_raw;
    if (tid_opaque() < 16) ((LAS unsigned*)(lds + 131072))[tid_opaque()] = 0u;
    __syncthreads();
    { LOADP(); (void)xcd_barrier_post((unsigned*)(ws + WS_BAR), (volatile LAS unsigned*)(lds + 131072 + 32)); }
#ifndef NO_P0
    { LOADP(); phase0(p, lds, G); }
#endif
    GSYNC_CG();
    { LOADP(); phase0b(p, G); }
    GSYNC();
    { LOADP(); rowop<true, false, true>(p, G, MT, 0.f, nullptr, 0, nullptr, (const float*)(ws + WS_MOD), 0, p.norm_g); }
    GSYNC();

#pragma unroll 1
    for (int layer = 0; layer < 4; ++layer) {
#pragma unroll 1
        for (int half = 0; half < 2; ++half) {
            if (half == 1) {
                const int nsteps = layer == 2 ? 3 : 1;
#pragma unroll 1
                for (int s = 0; s < nsteps; ++s) {
#ifndef NO_G3
                    { LOADP(); bf16* A = (bf16*)(ws + WS_A); bf16* U = (bf16*)(ws + WS_U);
                      pg8::Gemm g; pg8::EpiBf16Rope E;
                      if (layer == 0)      { g = pg8::Gemm{A, (const bf16*)(ws + WS_DA_IN), MT, 3072, 1024}; E = pg8::EpiBf16Rope{U, 3072, 1, 2048, NL / 256}; }
                      else if (layer == 1) { g = pg8::Gemm{A, (const bf16*)(ws + WS_GA_IN), MT, 1536, 1024}; E = pg8::EpiBf16Rope{U, 1536, 0, 0, 0}; }
                      else if (layer == 3) { g = pg8::Gemm{A, (const bf16*)(ws + WS_SWA_IN), MT, 1280, 1024}; E = pg8::EpiBf16Rope{U, 1280, 1, 1152, NL / 256}; }
                      else if (s == 0)     { g = pg8::Gemm{A, (const bf16*)(ws + WS_MLA_IN), MT, 512, 1024}; E = pg8::EpiBf16Rope{(bf16*)(ws + WS_CIN), 512, 0, 0, 0}; }
                      else if (s == 1)     { g = pg8::Gemm{(const bf16*)(ws + WS_AQ), (const bf16*)(ws + WS_MLA_UQ), MT, 1536, 256}; E = pg8::EpiBf16Rope{(bf16*)(ws + WS_MQ), 1536, 2, 0, NL / 256}; }
                      else                 { g = pg8::Gemm{(const bf16*)(ws + WS_AKV), (const bf16*)(ws + WS_MLA_UKV), MT, 2048, 128};     E = pg8::EpiBf16Rope{(bf16*)(ws + WS_MKV), 2048, 0, 0, 0}; }
                      pg8::StaticOrder S; S.init(g.M, g.N, G, (int)bid_opaque());
                      pg8::gemm_phase<pg8::EpiBf16Rope, pg8::StaticOrder, GALIGN, GSP2>(lds, g, S, E); }
#endif
                    if (layer == 2 && s == 1) continue;
                    GSYNC();
                    if (layer == 1 || (layer == 2 && s == 0)) {
                        { LOADP();
                          if (layer == 1) post_ga(p, G);
                          else post_mla1(p, G); }
                        GSYNC();
                    }
                }
                if (layer == 0) {
#ifndef NO_ATT0
                    { LOADP(); const bf16* U = (const bf16*)(ws + WS_U);
                      AttnDesc d{U, U, U, U, (bf16*)(ws + WS_Y), 3072, 3072, 0, 3072, 2048, 8, 64, 1024, 1, 64, 0, 2048, 2, 128, 128, 0.125f, nullptr, (bf16*)(ws + WS_A), uptr(p.da_subln), uptr(p.da_lambda), 0.8f - 0.6f};
                      attn_phase<64, 64, 128, false, true>(lds, d, true, G); }
#endif
                } else if (layer == 1) {
#ifndef NO_ATT1
                    { LOADP(); const bf16* U = (const bf16*)(ws + WS_U);
                      AttnDesc d{U, U, U, U, (bf16*)(ws + WS_A), 1536, 1536, 0, 1536, 1024, 8, 128, 1024, 4, 128, 0, 1280, 4, 128, 128, 0.08838834764831845f, nullptr, nullptr, uptr(p.ga_q_norm), nullptr, 0.f};
                      attn_phase<128, 128, 128, false>(lds, d, true, G); }
#endif
                } else if (layer == 2) {
#ifndef NO_ATT2
                    { LOADP(); const bf16* q = (const bf16*)(ws + WS_MQ); const bf16* kv = (const bf16*)(ws + WS_MKV);
                      AttnDesc d{q, kv, (const bf16*)(ws + WS_CIN), kv, (bf16*)(ws + WS_A), 1536, 2048, 512, 2048, 1024, 16, 96, 0, 1, 128, 384, 64, 1, 128, 64, 0.10206207261596575f, nullptr};
                      attn_phase<96, 64, 64, false>(lds, d, true, G); }
#endif
                } else {
#ifndef NO_ATT3
                    { LOADP(); const bf16* U = (const bf16*)(ws + WS_U);
                      AttnDesc d{U, U, U, U, (bf16*)(ws + WS_A), 1280, 1280, 0, 1280, 1024, 16, 64, 1024, 8, 64, 0, 1152, 8, 64, 64, 0.125f, p.swa_sink};
                      attn_phase<64, 64, 64, true>(lds, d, false, G); }
#endif
                }
                GSYNC();
#ifndef NO_G4
                { LOADP();
                  const size_t wo = layer == 0 ? WS_DA_OUT : layer == 1 ? WS_GA_OUT : layer == 2 ? WS_MLA_OUT : WS_SWA_OUT;
                  pg8::Gemm g{(const bf16*)(ws + WS_A), (const bf16*)(ws + wo), layer < 3 ? MT : NL, 1024, 1024}; pg8::EpiBf16S E{(bf16*)(ws + WS_Y), 1024};
                  pg8::StaticOrder S; S.init(g.M, g.N, G, (int)bid_opaque());
                  pg8::gemm_phase<pg8::EpiBf16S, pg8::StaticOrder, GALIGN, GSP2>(lds, g, S, E); }
#endif
                GSYNC();
                { LOADP(); const float* gl = p.norm_g + (size_t)layer * 6 * DM; const float* modl = (const float*)(ws + WS_MOD) + (size_t)layer * 9 * NMOD;
                  rowop<false, true, true>(p, G, layer < 3 ? MT : NL, 1.0f, modl, 5, gl + 3 * DM, modl, 6, gl + 4 * DM); }
                GSYNC();
            }
#ifndef NO_G1
            { LOADP();
              pg8::Gemm g{(const bf16*)(ws + WS_A), (const bf16*)(ws + WS_FIN + (size_t)(layer * 2 + half) * FIN_BYTES), (half == 0 || layer < 3) ? MT : NL, 2 * DFF, 1024}; pg8::EpiSwiGLU E{(bf16*)(ws + WS_U), DFF};
              pg8::StaticOrder S; S.init(g.M, g.N, G, (int)bid_opaque());
              pg8::gemm_phase<pg8::EpiSwiGLU, pg8::StaticOrder, GALIGN, GSP2>(lds, g, S, E); }
#endif
            GSYNC();
#define ROWOP_FFN(row0_, nrows_, gw_, ngw_) do { const float* gl = p.norm_g + (size_t)layer * 6 * DM; const float* modl = (const float*)(ws + WS_MOD) + (size_t)layer * 9 * NMOD; \
              if (half == 0) rowop_rows<false, true, true>(p, row0_, nrows_, gw_, ngw_, 0.5f, modl, 2, gl + 1 * DM, modl, 3, gl + 2 * DM); \
              else if (layer < 3) rowop_rows<false, true, true>(p, row0_, nrows_, gw_, ngw_, 0.5f, modl, 8, gl + 5 * DM, modl + 9 * NMOD, 0, gl + 6 * DM); \
              else rowop_rows<false, true, false>(p, row0_, nrows_, gw_, ngw_, 0.5f, modl, 8, gl + 5 * DM, nullptr, 0, nullptr); } while (0)
            { const bool wctx = (half == 0 || layer < 3);
#pragma unroll 1
              for (int pass = 0; pass < (wctx ? 2 : 1); ++pass) {
                  if (pass == 0 || (int)bid_opaque() < 32) {
#ifndef NO_G2
                      { LOADP();
                        pg8::Gemm g{(const bf16*)(ws + WS_U) + (pass ? (size_t)NL * DFF : 0), (const bf16*)(ws + WS_FOUT + (size_t)(layer * 2 + half) * FOUT_BYTES), pass ? NC : NL, 1024, DFF};
                        pg8::EpiBf16S E{(bf16*)(ws + WS_Y) + (pass ? (size_t)NL * DM : 0), 1024};
                        pg8::StaticOrder S; S.init(g.M, g.N, pass ? 32 : G, (int)bid_opaque());
                        pg8::gemm_phase<pg8::EpiBf16S, pg8::StaticOrder, GALIGN, GSP2>(lds, g, S, E); }
#endif
                  } else { LOADP(); ROWOP_FFN(0, NL, ((int)bid_opaque() - 32) * 8 + (tid_opaque() >> 6), (G - 32) * 8); }
                  GSYNC();
              }
              { LOADP(); if (wctx) ROWOP_FFN(NL, NC, (int)bid_opaque() * 8 + (tid_opaque() >> 6), G * 8); else ROWOP_FFN(0, NL, (int)bid_opaque() * 8 + (tid_opaque() >> 6), G * 8); }
              if (!(layer == 3 && half == 1)) GSYNC();
            }
#undef ROWOP_FFN
        }
    }
}

extern "C" void kernel_launch(void* const* d_in, const int* in_sizes, int n_in, void* d_out, int out_size, void* d_ws, size_t ws_size, hipStream_t stream) {
    static int grid_blocks = 0;
    if (grid_blocks == 0) {
        if (n_in != 26 || out_size != NL * DM || ws_size < WS_END) { fprintf(stderr, "kernel_launch: unexpected shapes (n_in %d, out %d, ws %zu)\n", n_in, out_size, ws_size); grid_blocks = -1; return; }
        int dev = 0, cus = 0, per_cu = 0;
        hipGetDevice(&dev);
        hipDeviceGetAttribute(&cus, hipDeviceAttributeMultiprocessorCount, dev);
        if (hipFuncSetAttribute((const void*)fwd_megakernel, hipFuncAttributeMaxDynamicSharedMemorySize, LDS_BYTES) != hipSuccess) { fprintf(stderr, "kernel_launch: hipFuncSetAttribute failed\n"); grid_blocks = -1; return; }
        if (hipOccupancyMaxActiveBlocksPerMultiprocessor(&per_cu, (const void*)fwd_megakernel, NTHREADS, LDS_BYTES) != hipSuccess || per_cu < 1) { fprintf(stderr, "kernel_launch: occupancy query failed (%d)\n", per_cu); per_cu = 1; (void)hipGetLastError(); }
        grid_blocks = cus * (per_cu > 1 ? 1 : per_cu);
    }
    if (grid_blocks < 0) return;
    Params p{};
    const float** pp = (const float**)&p;
    for (int i = 0; i < 26; ++i) pp[i] = (const float*)d_in[i];
    p.out = (float*)d_out; p.ws = (unsigned char*)d_ws;
    if (hipMemsetAsync((char*)d_ws + WS_BAR, 0, XCD_BAR_WORDS * 4, stream) != hipSuccess) { fprintf(stderr, "kernel_launch: memset failed\n"); return; }
    void* args[] = {&p};
    hipError_t e = hipLaunchCooperativeKernel((const void*)fwd_megakernel, dim3(grid_blocks), dim3(NTHREADS), args, LDS_BYTES, stream);
    if (e != hipSuccess) fprintf(stderr, "cooperative launch failed: %s (grid %d)\n", hipGetErrorString(e), grid_blocks);
}
```

```cpp
#include <hip/hip_runtime.h>
#include <hip/hip_cooperative_groups.h>
#include <cstdio>
#include <cstdint>
#include <cmath>
namespace cg = cooperative_groups;
__device__ __forceinline__ int tid_opaque() { int t = threadIdx.x; asm volatile("" : "+v"(t)); return t; }
__device__ __forceinline__ int bid_opaque() { int b = blockIdx.x; asm volatile("" : "+s"(b)); return b; }
namespace pg8 {
#define PG8_LAS __attribute__((address_space(3)))
typedef unsigned short bf16_t;
typedef short bf16x8 __attribute__((ext_vector_type(8)));
typedef float f32x4 __attribute__((ext_vector_type(4)));
typedef unsigned u32x4 __attribute__((ext_vector_type(4)));
constexpr int BM = 256, BK = 64, HALF = 128, HTB = HALF * BK * 2  , STAGE_BYTES = 8 * HTB, NXCD = 8, WGM = 8;

__host__ __device__ __forceinline__ int lds_byte(int r, int c) { const int st = (r >> 4) * 2 + (c >> 5), rr = r & 15, cc = c & 31, ob = rr * 64 + cc * 2; return st * 1024 + (ob ^ (((ob >> 9) & 1) << 5)); }
__host__ __device__ __forceinline__ void stage_rc(int b, int& R, int& C) { const int st = b / 1024, sb = b % 1024, swz = sb ^ (((sb >> 9) & 1) << 5); R = (st >> 1) * 16 + swz / 64; C = (st & 1) * 32 + (swz % 64) / 2; }
__host__ __device__ __forceinline__ int perm32(int rho) { const int n = rho >> 4, i = rho & 15; return 8 * (i >> 2) + 4 * n + (i & 3); }

struct Unit { int pm, pn; };
struct Gemm { const bf16_t* A; const bf16_t* Bt; int M, N, K; };

struct StaticOrder {
    int nM, nN, nwg, G, c;
    __host__ __device__ void init(int M, int N, int G_, int c_) { nM = M / BM; nN = N / BM; nwg = nM * nN; G = G_; c = c_; }
    __host__ __device__ bool next(int i, Unit& u) const {
        const long L = (long)i * G + c; if (L >= nwg) return false;
        int wgid = (int)L; { const int q = nwg / NXCD, r = nwg % NXCD, xcd = wgid % NXCD, off = wgid / NXCD; wgid = (xcd < r ? xcd * (q + 1) : r * (q + 1) + (xcd - r) * q) + off; }
        const int nig = WGM * nN, gid = wgid / nig, fm = gid * WGM, gsz = (nM - fm) < WGM ? (nM - fm) : WGM;
        u.pm = fm + ((wgid % nig) % gsz); u.pn = (wgid % nig) / gsz; return true;
    }
    __device__ __forceinline__ void a_ready(const Unit&) const {}
    __device__ __forceinline__ void done(const Unit&) const {}
};

__device__ __forceinline__ unsigned cvt_pk_bf16(float lo, float hi) { unsigned r; asm volatile("v_cvt_pk_bf16_f32 %0, %1, %2" : "=v"(r) : "v"(lo), "v"(hi)); return r; }
struct EpiBf16S {
    static constexpr bool PERM = true, AFTER_DRAIN = false;
    bf16_t* O; int ldc;
    __device__ __forceinline__ void operator()(const f32x4 (&acc)[2][2][4][2], const Unit& u, int wr, int wc, int fr, int fq) const {
        const int row0 = u.pm * BM + wr * 64 + fr; const int col0 = u.pn * BM + wc * 32 + 8 * fq;
#pragma unroll
        for (int ai = 0; ai < 2; ++ai)
#pragma unroll
            for (int m = 0; m < 4; ++m) { bf16_t* rowp = O + (size_t)(row0 + ai * HALF + m * 16) * ldc + col0;
#pragma unroll
                for (int bj = 0; bj < 2; ++bj) { const f32x4 v0 = acc[ai][bj][m][0], v1 = acc[ai][bj][m][1];
                    u32x4 w; w.x = cvt_pk_bf16(v0[0], v0[1]); w.y = cvt_pk_bf16(v0[2], v0[3]); w.z = cvt_pk_bf16(v1[0], v1[1]); w.w = cvt_pk_bf16(v1[2], v1[3]);
                    *(u32x4*)(rowp + bj * HALF) = w; } }
    }
};
__device__ __forceinline__ float silu_mul(float g, float u) { return g * __builtin_amdgcn_rcpf(1.0f + __builtin_amdgcn_exp2f(-1.4426950408889634f * g)) * u; }
struct EpiSwiGLU {
    static constexpr bool PERM = true, AFTER_DRAIN = false;
    bf16_t* O; int ldc;
    __device__ __forceinline__ void operator()(const f32x4 (&acc)[2][2][4][2], const Unit& u, int wr, int wc, int fr, int fq) const {
        const int row0 = u.pm * BM + wr * 64 + fr; const int col0 = u.pn * HALF + wc * 32 + 8 * fq;
#pragma unroll
        for (int ai = 0; ai < 2; ++ai)
#pragma unroll
            for (int m = 0; m < 4; ++m) { bf16_t* rowp = O + (size_t)(row0 + ai * HALF + m * 16) * ldc + col0;
                const f32x4 g0 = acc[ai][0][m][0], g1 = acc[ai][0][m][1], u0 = acc[ai][1][m][0], u1 = acc[ai][1][m][1];
                u32x4 w;
                w.x = cvt_pk_bf16(silu_mul(g0[0], u0[0]), silu_mul(g0[1], u0[1])); w.y = cvt_pk_bf16(silu_mul(g0[2], u0[2]), silu_mul(g0[3], u0[3]));
                w.z = cvt_pk_bf16(silu_mul(g1[0], u1[0]), silu_mul(g1[1], u1[1])); w.w = cvt_pk_bf16(silu_mul(g1[2], u1[2]), silu_mul(g1[3], u1[3]));
                *(u32x4*)rowp = w; }
    }
};
struct EpiF32 {
    static constexpr bool PERM = false, AFTER_DRAIN = false;
    float* O; int ldc;
    __device__ __forceinline__ void operator()(const f32x4 (&acc)[2][2][4][2], const Unit& u, int wr, int wc, int fr, int fq) const {
        const int col0 = u.pn * BM + wc * 32 + 4 * fq;
#pragma unroll
        for (int ai = 0; ai < 2; ++ai)
#pragma unroll
            for (int m = 0; m < 4; ++m) { float* rowp = O + (size_t)(u.pm * BM + ai * HALF + wr * 64 + m * 16 + fr) * ldc + col0;
#pragma unroll
                for (int bj = 0; bj < 2; ++bj)
#pragma unroll
                    for (int n = 0; n < 2; ++n) *(f32x4*)(rowp + bj * HALF + n * 16) = acc[ai][bj][m][n]; }
    }
};

struct EpiBf16Rope {
    static constexpr bool PERM = true, AFTER_DRAIN = false;
    bf16_t* O; int ldc; int mode; int col_limit; int lat_panels;
    __device__ __forceinline__ void operator()(const f32x4 (&acc)[2][2][4][2], const Unit& u, int wr, int wc, int fr, int fq) const {
        const int row0 = u.pm * BM + wr * 64 + fr; const int col0 = u.pn * BM + wc * 32 + 8 * fq;
        const bool lat = mode != 0 && u.pm < lat_panels;
        bool rot[2]; float fr4[2][4]; bool rowaxis[2];
#pragma unroll
        for (int bj = 0; bj < 2; ++bj) { const int col = col0 + bj * HALF; int j0, nax;
            if (mode == 2) { const int c96 = col % 96; rot[bj] = lat && c96 >= 64; j0 = (c96 - 64) >> 1; nax = 8; }
            else { rot[bj] = lat && col < col_limit; j0 = (col & 63) >> 1; nax = 16; }
            rowaxis[bj] = j0 < nax; const int f0 = j0 & (nax - 1);
#pragma unroll
            for (int e = 0; e < 4; ++e) fr4[bj][e] = __builtin_amdgcn_exp2f(-13.287712379549449f * (float)(f0 + e) / (float)nax); }
#pragma unroll
        for (int ai = 0; ai < 2; ++ai)
#pragma unroll
            for (int m = 0; m < 4; ++m) { const int row = row0 + ai * HALF + m * 16; bf16_t* rowp = O + (size_t)row * ldc + col0;
                const int s = row & 4095; const float prow = (float)(s >> 6), pcol = (float)(s & 63);
#pragma unroll
                for (int bj = 0; bj < 2; ++bj) { f32x4 v0 = acc[ai][bj][m][0], v1 = acc[ai][bj][m][1];
                    if (rot[bj]) { const float pos = rowaxis[bj] ? prow : pcol;
                        float cs, sn, t;
                        cs = __cosf(pos * fr4[bj][0]); sn = __sinf(pos * fr4[bj][0]); t = v0[0] * cs - v0[1] * sn; v0[1] = v0[0] * sn + v0[1] * cs; v0[0] = t;
                        cs = __cosf(pos * fr4[bj][1]); sn = __sinf(pos * fr4[bj][1]); t = v0[2] * cs - v0[3] * sn; v0[3] = v0[2] * sn + v0[3] * cs; v0[2] = t;
                        cs = __cosf(pos * fr4[bj][2]); sn = __sinf(pos * fr4[bj][2]); t = v1[0] * cs - v1[1] * sn; v1[1] = v1[0] * sn + v1[1] * cs; v1[0] = t;
                        cs = __cosf(pos * fr4[bj][3]); sn = __sinf(pos * fr4[bj][3]); t = v1[2] * cs - v1[3] * sn; v1[3] = v1[2] * sn + v1[3] * cs; v1[2] = t; }
                    u32x4 w; w.x = cvt_pk_bf16(v0[0], v0[1]); w.y = cvt_pk_bf16(v0[2], v0[3]); w.z = cvt_pk_bf16(v1[0], v1[1]); w.w = cvt_pk_bf16(v1[2], v1[3]);
                    *(u32x4*)(rowp + bj * HALF) = w; } }
    }
};
template <class Epi, class Sched, bool ALIGN_EPI = false, bool SP2 = false>
__device__ __forceinline__ void gemm_phase(PG8_LAS unsigned char* lds, const Gemm g, const Sched& S, const Epi& E) {
    const int tid = tid_opaque(), wid = __builtin_amdgcn_readfirstlane(tid >> 6), lane = tid & 63, wr = wid >> 2, wc = wid & 3, fr = lane & 15, fq = lane >> 4;
    const int K = g.K, nt = K / BK;
    unsigned voffA[2], voffB[2];
#pragma unroll
    for (int i = 0; i < 2; ++i) { int R, C; stage_rc(tid * 16 + i * 8192, R, C); const int Rb = Epi::PERM ? ((R & ~31) + perm32(R & 31)) : R;
        voffA[i] = (unsigned)(R * K + C) * 2u; voffB[i] = (unsigned)(Rb * K + C) * 2u; }
    const size_t kstep = (size_t)(BK * 2);
    const size_t hstep = (size_t)HALF * K * 2;
    const size_t tstep = 2 * hstep;
    const unsigned ldsw = (unsigned)wid * 1024u;
    const int aoff = lds_byte(wr * 64 + fr, fq * 8), boff = lds_byte(wc * 32 + fr, fq * 8);
#define PG8_SA(b, h) (((b) * 2 + (h)) * HTB)
#define PG8_SB(b, h) ((4 + (b) * 2 + (h)) * HTB)
#define PG8_STAGE(bufoff, gbase, voff) do { _Pragma("unroll") for (int _i = 0; _i < 2; ++_i) \
        __builtin_amdgcn_global_load_lds((const unsigned*)((const char*)(gbase) + (voff)[_i]), (PG8_LAS unsigned*)(lds + (bufoff) + ldsw + _i * 8192), 16, 0, 0); } while (0)
#define PG8_LDA(dst, b, h) do { _Pragma("unroll") for (int m = 0; m < 4; ++m) _Pragma("unroll") for (int k = 0; k < 2; ++k) dst[m][k] = *(const PG8_LAS bf16x8*)(lds + PG8_SA(b, h) + aoff + m * 2048 + k * 1024); } while (0)
#define PG8_LDB(dst, b, h) do { _Pragma("unroll") for (int n = 0; n < 2; ++n) _Pragma("unroll") for (int k = 0; k < 2; ++k) dst[n][k] = *(const PG8_LAS bf16x8*)(lds + PG8_SB(b, h) + boff + n * 2048 + k * 1024); } while (0)
#define PG8_MMA(ai, bj, At, Bt) do { __builtin_amdgcn_s_setprio(1); _Pragma("unroll") for (int m = 0; m < 4; ++m) _Pragma("unroll") for (int n = 0; n < 2; ++n) _Pragma("unroll") for (int k = 0; k < 2; ++k) \
        acc[ai][bj][m][n] = __builtin_amdgcn_mfma_f32_16x16x32_bf16(Bt[n][k], At[m][k], acc[ai][bj][m][n], 0, 0, 0); __builtin_amdgcn_s_setprio(0); } while (0)
#define PG8_WAIT_V(n) asm volatile("s_waitcnt vmcnt(" #n ")" ::: "memory")
#define PG8_WAIT_L(n) asm volatile("s_waitcnt lgkmcnt(" #n ")" ::: "memory")
#define PG8_BAR __builtin_amdgcn_s_barrier()
#define PG8_SCHED __builtin_amdgcn_sched_barrier(0)
    Unit cur, nxt; int ui = 0;
    if (!S.next(0, cur)) return;
    f32x4 acc[2][2][4][2];
#pragma unroll
    for (int a = 0; a < 2; ++a)
#pragma unroll
        for (int b = 0; b < 2; ++b)
#pragma unroll
            for (int m = 0; m < 4; ++m)
#pragma unroll
                for (int n = 0; n < 2; ++n) acc[a][b][m][n] = (f32x4){0.f, 0.f, 0.f, 0.f};
    bf16x8 At[4][2], B0[2][2], B1[2][2];
    const char* cA = (const char*)g.A + (size_t)cur.pm * tstep; const char* cB = (const char*)g.Bt + (size_t)cur.pn * tstep;
    S.a_ready(cur);
    if constexpr (SP2) {
        PG8_STAGE(PG8_SB(0, 0), cB, voffB); PG8_STAGE(PG8_SB(0, 1), cB + hstep, voffB); PG8_STAGE(PG8_SA(0, 0), cA, voffA); PG8_STAGE(PG8_SA(0, 1), cA + hstep, voffA);
        if (wr == 1) PG8_BAR;
        PG8_WAIT_V(2); PG8_BAR;
        PG8_STAGE(PG8_SB(1, 0), cB + kstep, voffB); PG8_STAGE(PG8_SA(1, 0), cA + kstep, voffA); PG8_STAGE(PG8_SB(1, 1), cB + hstep + kstep, voffB);
        PG8_WAIT_V(6); PG8_BAR;
    } else {
        PG8_STAGE(PG8_SB(0, 0), cB, voffB); PG8_STAGE(PG8_SA(0, 0), cA, voffA); PG8_STAGE(PG8_SB(0, 1), cB + hstep, voffB); PG8_STAGE(PG8_SA(0, 1), cA + hstep, voffA);
        if (wr == 1) PG8_BAR;
        PG8_WAIT_V(4); PG8_BAR;
        PG8_STAGE(PG8_SB(1, 0), cB + kstep, voffB); PG8_STAGE(PG8_SA(1, 0), cA + kstep, voffA); PG8_STAGE(PG8_SB(1, 1), cB + hstep + kstep, voffB);
        PG8_WAIT_V(6); PG8_BAR;
    }
    for (;;) {
        const bool has_next = S.next(ui + 1, nxt);
        const char* nA = has_next ? (const char*)g.A + (size_t)nxt.pm * tstep : cA; const char* nB = has_next ? (const char*)g.Bt + (size_t)nxt.pn * tstep : cB;
        for (int t = 0; t < nt; t += 2) {
            const bool last = (t == nt - 2);
            const char* a1 = cA + (size_t)(t + 1) * kstep;
            const char* a2 = last ? nA : cA + (size_t)(t + 2) * kstep; const char* b2 = last ? nB : cB + (size_t)(t + 2) * kstep;
            const char* a3 = a2 + kstep; const char* b3 = b2 + kstep;
            if (last && has_next) S.a_ready(nxt);
            if constexpr (SP2) {
            PG8_LDB(B0, 0, 0); PG8_LDB(B1, 0, 1); PG8_SCHED; PG8_LDA(At, 0, 0); PG8_STAGE(PG8_SA(1, 1), a1 + hstep, voffA);
            PG8_WAIT_V(8); PG8_WAIT_L(0); PG8_BAR; PG8_MMA(0, 0, At, B0); PG8_MMA(0, 1, At, B1); PG8_BAR; PG8_SCHED;
            PG8_LDA(At, 0, 1); PG8_STAGE(PG8_SB(0, 0), b2, voffB); PG8_STAGE(PG8_SB(0, 1), b2 + hstep, voffB); PG8_STAGE(PG8_SA(0, 0), a2, voffA);
            PG8_WAIT_V(8); PG8_WAIT_L(0); PG8_BAR; PG8_MMA(1, 0, At, B0); PG8_MMA(1, 1, At, B1); PG8_BAR; PG8_SCHED;
            PG8_LDB(B0, 1, 0); PG8_LDB(B1, 1, 1); PG8_SCHED; PG8_LDA(At, 1, 0); PG8_STAGE(PG8_SA(0, 1), a2 + hstep, voffA);
            PG8_WAIT_V(8); PG8_WAIT_L(0); PG8_BAR; PG8_MMA(0, 0, At, B0); PG8_MMA(0, 1, At, B1); PG8_BAR; PG8_SCHED;
            PG8_LDA(At, 1, 1); PG8_STAGE(PG8_SB(1, 0), b3, voffB); PG8_STAGE(PG8_SB(1, 1), b3 + hstep, voffB); PG8_STAGE(PG8_SA(1, 0), a3, voffA);
            PG8_WAIT_V(8); PG8_WAIT_L(0); PG8_BAR; PG8_MMA(1, 0, At, B0); PG8_MMA(1, 1, At, B1); PG8_BAR; PG8_SCHED;
            } else {
            PG8_LDB(B0, 0, 0); PG8_SCHED; PG8_LDA(At, 0, 0); PG8_STAGE(PG8_SA(1, 1), a1 + hstep, voffA);
            PG8_WAIT_L(8); PG8_BAR; PG8_WAIT_L(0); PG8_MMA(0, 0, At, B0); PG8_BAR; PG8_SCHED;
            PG8_LDB(B1, 0, 1); PG8_STAGE(PG8_SB(0, 0), b2, voffB);
            PG8_BAR; PG8_WAIT_L(0); PG8_MMA(0, 1, At, B1); PG8_BAR;
            PG8_LDA(At, 0, 1); PG8_STAGE(PG8_SA(0, 0), a2, voffA);
            PG8_BAR; PG8_WAIT_L(0); PG8_MMA(1, 0, At, B0); PG8_BAR; PG8_SCHED;
            PG8_STAGE(PG8_SB(0, 1), b2 + hstep, voffB);
            PG8_WAIT_V(6); PG8_BAR; PG8_MMA(1, 1, At, B1); PG8_BAR;
            PG8_LDB(B0, 1, 0); PG8_SCHED; PG8_LDA(At, 1, 0); PG8_STAGE(PG8_SA(0, 1), a2 + hstep, voffA);
            PG8_WAIT_L(8); PG8_BAR; PG8_WAIT_L(0); PG8_MMA(0, 0, At, B0); PG8_BAR; PG8_SCHED;
            PG8_LDB(B1, 1, 1); PG8_STAGE(PG8_SB(1, 0), b3, voffB);
            PG8_BAR; PG8_WAIT_L(0); PG8_MMA(0, 1, At, B1); PG8_BAR;
            PG8_LDA(At, 1, 1); PG8_STAGE(PG8_SA(1, 0), a3, voffA);
            PG8_BAR; PG8_WAIT_L(0); PG8_MMA(1, 0, At, B0); PG8_BAR; PG8_SCHED;
            PG8_STAGE(PG8_SB(1, 1), b3 + hstep, voffB);
            PG8_WAIT_V(6); PG8_BAR; PG8_MMA(1, 1, At, B1); PG8_BAR;
            }
        }
        if constexpr (ALIGN_EPI) { if (wr == 0) PG8_BAR; }
        if constexpr (!Epi::AFTER_DRAIN) { E(acc, cur, wr, wc, fr, fq); S.done(cur); }
        if (!has_next) break;
#pragma unroll
        for (int a = 0; a < 2; ++a)
#pragma unroll
            for (int b = 0; b < 2; ++b)
#pragma unroll
                for (int m = 0; m < 4; ++m)
#pragma unroll
                    for (int n = 0; n < 2; ++n) acc[a][b][m][n] = (f32x4){0.f, 0.f, 0.f, 0.f};
        cur = nxt; cA = nA; cB = nB; ++ui;
        if constexpr (ALIGN_EPI) { if (wr == 1) PG8_BAR; }
    }
    PG8_WAIT_V(0);
    if constexpr (!ALIGN_EPI) { if (wr == 0) PG8_BAR; }
    PG8_BAR;
    if constexpr (Epi::AFTER_DRAIN) { E.fused(acc, cur, wr, wc, fr, fq, lds, wid, lane); S.done(cur); }
#undef PG8_SA
#undef PG8_SB
#undef PG8_STAGE
#undef PG8_LDA
#undef PG8_LDB
#undef PG8_MMA
#undef PG8_WAIT_V
#undef PG8_WAIT_L
#undef PG8_BAR
#undef PG8_SCHED
}
}
#define LAS __attribute__((address_space(3)))
typedef unsigned short bf16;
typedef unsigned u32x4 __attribute__((ext_vector_type(4)));
typedef unsigned u32x2 __attribute__((ext_vector_type(2)));
typedef float f32x4 __attribute__((ext_vector_type(4)));
typedef float f32x16 __attribute__((ext_vector_type(16)));
typedef short bf16x8 __attribute__((ext_vector_type(8)));
typedef short s16x4 __attribute__((ext_vector_type(4)));

constexpr int DM = 1024, NB = 8, SEQ = 4096, CTXL = 256, NL = NB * SEQ, NC = NB * CTXL, MT = NL + NC, DFF = 2816, NMOD = 9 * DM;
constexpr float EPS = 1e-6f;
constexpr float LOG2E = 1.4426950408889634f;
constexpr int NTHREADS = 512;
constexpr int LDS_BYTES = 131072 + 1024;

struct Params {
    const float *x, *c, *ctx, *c_ctx, *ada_w, *ada_b, *norm_g, *ffn_w_in, *ffn_w_out;
    const float *da_w_in, *da_lambda, *da_subln, *da_w_out;
    const float *ga_w_in, *ga_q_norm, *ga_k_norm, *ga_w_out;
    const float *mla_w_in, *mla_q_norm, *mla_kv_norm, *mla_w_uq, *mla_w_ukv, *mla_w_out;
    const float *swa_w_in, *swa_sink, *swa_w_out;
    float* out; unsigned char* ws;
};

constexpr size_t MiB = (size_t)1 << 20;
constexpr size_t WS_BAR = MiB + MiB / 2;
constexpr size_t WS_MOD = 0, WS_PART = 2 * MiB, WS_HC = 24 * MiB;
constexpr size_t WS_FIN = 32 * MiB, FIN_BYTES = 11 * MiB;
constexpr size_t WS_FOUT = 120 * MiB, FOUT_BYTES = 5 * MiB + MiB / 2;
constexpr size_t WS_DA_IN = 164 * MiB, WS_DA_OUT = 170 * MiB, WS_GA_IN = 172 * MiB, WS_GA_OUT = 175 * MiB;
constexpr size_t WS_MLA_IN = 177 * MiB, WS_MLA_UQ = 178 * MiB, WS_MLA_UKV = 179 * MiB, WS_MLA_OUT = 180 * MiB;
constexpr size_t WS_SWA_IN = 182 * MiB, WS_SWA_OUT = 185 * MiB;
constexpr size_t WS_A = 188 * MiB;
constexpr size_t WS_Y = 256 * MiB;
constexpr size_t WS_U = 392 * MiB;
constexpr size_t WS_END = 640 * MiB;
constexpr size_t WS_CIN = WS_Y, WS_AQ = WS_Y + 34 * MiB, WS_AKV = WS_Y + 51 * MiB, WS_MQ = WS_U, WS_MKV = WS_U + 102 * MiB;
constexpr int NKC = 16;

__device__ __forceinline__ float wave_sum(float v) {
#pragma unroll
    for (int o = 1; o < 64; o <<= 1) v += __shfl_xor(v, o);
    return v;
}
__device__ __forceinline__ unsigned pk2(float lo, float hi) { return pg8::cvt_pk_bf16(lo, hi); }
__device__ __forceinline__ float bflo(unsigned w) { return __uint_as_float(w << 16); }
__device__ __forceinline__ float bfhi(unsigned w) { return __uint_as_float(w & 0xffff0000u); }
__device__ __forceinline__ float silu_f(float v) { return v / (1.0f + __expf(-v)); }

__device__ __forceinline__ void transpose_item(const float* __restrict__ W, int N, bf16* WT, int ldk, int k0, int n0, int drow0, LAS float* scr, int lane) {
#pragma unroll 8
    for (int i = 0; i < 32; ++i) { const int kk = 2 * i + (lane >> 5); scr[kk * 33 + (lane & 31)] = W[(size_t)(k0 + kk) * N + n0 + (lane & 31)]; }
    asm volatile("s_waitcnt lgkmcnt(0)" ::: "memory");
    const int c = lane & 7;
#pragma unroll
    for (int j = 0; j < 4; ++j) { const int n = (lane >> 3) + 8 * j; const LAS float* s = scr + (8 * c) * 33 + n;
        u32x4 o; o.x = pk2(s[0 * 33], s[1 * 33]); o.y = pk2(s[2 * 33], s[3 * 33]); o.z = pk2(s[4 * 33], s[5 * 33]); o.w = pk2(s[6 * 33], s[7 * 33]);
        *(u32x4*)(WT + (size_t)(drow0 + n) * ldk + k0 + 8 * c) = o; }
    asm volatile("s_waitcnt lgkmcnt(0)" ::: "memory");
}
__device__ __forceinline__ int swiglu_row(int n0) { return n0 < DFF ? (n0 >> 7) * 256 + (n0 & 127) : ((n0 - DFF) >> 7) * 256 + 128 + ((n0 - DFF) & 127); }

__device__ __forceinline__ void phase0(const Params& p, LAS unsigned char* lds, int G) {
    const int tid = tid_opaque(), lane = tid & 63, wid = tid >> 6;
    unsigned char* ws = p.ws;
    LAS float* sc = (LAS float*)lds;
    for (int i = tid; i < 9 * DM; i += NTHREADS) { const float v = i < 8 * DM ? p.c[i] : p.c_ctx[i - 8 * DM]; sc[i] = silu_f(v); }
    __syncthreads();
    {
        const int gt = bid_opaque() * NTHREADS + tid, GT = G * NTHREADS;
        float* part = (float*)(ws + WS_PART);
        for (int w = gt; w < 4 * NKC * (NMOD / 4); w += GT) {
            const int col4 = w % (NMOD / 4), kc = (w / (NMOD / 4)) % NKC, layer = w / ((NMOD / 4) * NKC);
            const float* wp = p.ada_w + ((size_t)layer * DM + kc * 64) * NMOD + col4 * 4;
            f32x4 acc[9];
#pragma unroll
            for (int r = 0; r < 9; ++r) acc[r] = (f32x4){0.f, 0.f, 0.f, 0.f};
#pragma unroll 4
            for (int k = 0; k < 64; ++k) {
                const f32x4 wv = *(const f32x4*)(wp + (size_t)k * NMOD);
#pragma unroll
                for (int r = 0; r < 9; ++r) { const float s = sc[r * DM + kc * 64 + k]; acc[r] += wv * s; }
            }
#pragma unroll
            for (int r = 0; r < 9; ++r) *(f32x4*)(part + ((size_t)(kc * 4 + layer) * 9 + r) * NMOD + col4 * 4) = acc[r];
        }
    }
    {
        LAS float* scr = (LAS float*)(lds + 40960) + wid * (64 * 33);
        const int gw = bid_opaque() * 8 + wid, NGW = G * 8;
        constexpr int I_FIN = 16 * 176, I_FOUT = 44 * 32, I_SQ = 16 * 32;
        constexpr int I_DA_IN = 16 * 96, I_GA_IN = 16 * 48, I_MLA_IN = 16 * 13, I_MLA_UQ = 4 * 48, I_MLA_UKV = 2 * 64, I_SWA_IN = 16 * 40;
        constexpr int TOTAL = 8 * I_FIN + 8 * I_FOUT + 4 * I_SQ + I_DA_IN + I_GA_IN + I_MLA_IN + I_MLA_UQ + I_MLA_UKV + I_SWA_IN;
        for (int it = gw; it < TOTAL; it += NGW) {
            int r = it;
            if (r < 8 * I_FIN) { const int f = r / I_FIN, rr = r % I_FIN, kb = rr / 176, n0 = (rr % 176) * 32;
                transpose_item(p.ffn_w_in + (size_t)f * DM * 2 * DFF, 2 * DFF, (bf16*)(ws + WS_FIN + f * FIN_BYTES), DM, kb * 64, n0, swiglu_row(n0), scr, lane); continue; }
            r -= 8 * I_FIN;
            if (r < 8 * I_FOUT) { const int f = r / I_FOUT, rr = r % I_FOUT, kb = rr / 32, n0 = (rr % 32) * 32;
                transpose_item(p.ffn_w_out + (size_t)f * DFF * DM, DM, (bf16*)(ws + WS_FOUT + f * FOUT_BYTES), DFF, kb * 64, n0, n0, scr, lane); continue; }
            r -= 8 * I_FOUT;
#define MATX(SRC, K_, N_, DST, LDK) { constexpr int nit_ = ((K_) / 64) * ((N_) / 32); if (r < nit_) { const int kb = r / ((N_) / 32), n0 = (r % ((N_) / 32)) * 32; \
                transpose_item(SRC, N_, (bf16*)(ws + (DST)), LDK, kb * 64, n0, n0, scr, lane); continue; } r -= nit_; }
            MATX(p.da_w_out, 1024, 1024, WS_DA_OUT, 1024)
            MATX(p.ga_w_out, 1024, 1024, WS_GA_OUT, 1024)
            MATX(p.mla_w_out, 1024, 1024, WS_MLA_OUT, 1024)
            MATX(p.swa_w_out, 1024, 1024, WS_SWA_OUT, 1024)
            MATX(p.da_w_in, 1024, 3072, WS_DA_IN, 1024)
            MATX(p.ga_w_in, 1024, 1536, WS_GA_IN, 1024)
            MATX(p.mla_w_in, 1024, 416, WS_MLA_IN, 1024)
            MATX(p.mla_w_uq, 256, 1536, WS_MLA_UQ, 256)
            MATX(p.mla_w_ukv, 128, 2048, WS_MLA_UKV, 128)
            MATX(p.swa_w_in, 1024, 1280, WS_SWA_IN, 1024)
#undef MATX
        }
        const int gt = bid_opaque() * NTHREADS + tid, GT = G * NTHREADS;
        for (int i = gt; i < 96 * 1024 / 8; i += GT) *(u32x4*)((bf16*)(ws + WS_MLA_IN) + (size_t)416 * 1024 + (size_t)i * 8) = (u32x4){0u, 0u, 0u, 0u};
    }
}
__device__ __forceinline__ void phase0b(const Params& p, int G) {
    const int gt = bid_opaque() * NTHREADS + tid_opaque(), GT = G * NTHREADS;
    const float* part = (const float*)(p.ws + WS_PART); float* mod = (float*)(p.ws + WS_MOD);
    for (int o = gt; o < 4 * 9 * NMOD / 4; o += GT) {
        const int col4 = o % (NMOD / 4), lr = o / (NMOD / 4), layer = lr / 9;
        f32x4 a = *(const f32x4*)(p.ada_b + (size_t)layer * NMOD + col4 * 4);
#pragma unroll
        for (int kc = 0; kc < NKC; ++kc) a += *(const f32x4*)(part + ((size_t)(kc * 4 + layer) * 9 + (lr % 9)) * NMOD + col4 * 4);
        *(f32x4*)(mod + (size_t)lr * NMOD + col4 * 4) = a;
    }
}

template <bool INIT, bool RES, bool NEXT>
__device__ __forceinline__ void rowop_rows(const Params& p, int row0, int nrows, int gw, int NGW, float wgt, const float* mod_res, int kgate, const float* g_post,
                                           const float* mod_next, int knext, const float* g_pre) {
    const int lane = tid_opaque() & 63;
    float* hc = (float*)(p.ws + WS_HC); const bf16* Y = (const bf16*)(p.ws + WS_Y); bf16* A = (bf16*)(p.ws + WS_A);
    for (int ri = gw; ri < nrows; ri += NGW) {
        const int row = row0 + ri;
        const bool lat = row < NL;
        const int mr = lat ? (row >> 12) : 8;
        float* hrow = lat ? p.out + (size_t)row * DM : hc + (size_t)(row - NL) * DM;
        f32x4 h[4];
        if (INIT) { const float* xr = lat ? p.x + (size_t)row * DM : p.ctx + (size_t)(row - NL) * DM;
#pragma unroll
            for (int j = 0; j < 4; ++j) h[j] = *(const f32x4*)(xr + (512 * (j >> 1) + 8 * lane + 4 * (j & 1))); }
        else if (lat) {
#pragma unroll
            for (int j = 0; j < 4; ++j) { const u32x2 hw = *(const u32x2*)((const bf16*)hrow + (512 * (j >> 1) + 8 * lane + 4 * (j & 1))); h[j] = (f32x4){bflo(hw.x), bfhi(hw.x), bflo(hw.y), bfhi(hw.y)}; } }
        else {
#pragma unroll
            for (int j = 0; j < 4; ++j) h[j] = *(const f32x4*)(hrow + (512 * (j >> 1) + 8 * lane + 4 * (j & 1))); }
        if (RES) {
            f32x4 y[4]; float ss = 0.f;
#pragma unroll
            for (int j = 0; j < 4; ++j) { const u32x2 yw = *(const u32x2*)(Y + (size_t)row * DM + (512 * (j >> 1) + 8 * lane + 4 * (j & 1))); y[j] = (f32x4){bflo(yw.x), bfhi(yw.x), bflo(yw.y), bfhi(yw.y)}; ss += (y[j].x * y[j].x + y[j].y * y[j].y) + (y[j].z * y[j].z + y[j].w * y[j].w); }
            const float r = wgt * __builtin_amdgcn_rsqf(wave_sum(ss) * (1.0f / DM) + EPS);
            const float* gate = mod_res + (size_t)mr * NMOD + kgate * DM;
#pragma unroll
            for (int j = 0; j < 4; ++j) { const f32x4 gt_ = *(const f32x4*)(gate + (512 * (j >> 1) + 8 * lane + 4 * (j & 1))), gp = *(const f32x4*)(g_post + (512 * (j >> 1) + 8 * lane + 4 * (j & 1))); h[j] += gt_ * (y[j] * r) * gp; }
        }
        if (INIT || RES) {
            if (lat && NEXT) {
#pragma unroll
                for (int j = 0; j < 4; ++j) { u32x2 w; w.x = pk2(h[j].x, h[j].y); w.y = pk2(h[j].z, h[j].w); *(u32x2*)((bf16*)hrow + (512 * (j >> 1) + 8 * lane + 4 * (j & 1))) = w; } }
            else {
#pragma unroll
                for (int j = 0; j < 4; ++j) *(f32x4*)(hrow + (512 * (j >> 1) + 8 * lane + 4 * (j & 1))) = h[j]; } }
        if (NEXT) {
            float ss = 0.f;
#pragma unroll
            for (int j = 0; j < 4; ++j) ss += (h[j].x * h[j].x + h[j].y * h[j].y) + (h[j].z * h[j].z + h[j].w * h[j].w);
            const float r = __builtin_amdgcn_rsqf(wave_sum(ss) * (1.0f / DM) + EPS);
            const float* shift = mod_next + (size_t)mr * NMOD + knext * DM; const float* scale = shift + DM;
#pragma unroll
            for (int j = 0; j < 4; ++j) { const f32x4 sh = *(const f32x4*)(shift + (512 * (j >> 1) + 8 * lane + 4 * (j & 1))), scl = *(const f32x4*)(scale + (512 * (j >> 1) + 8 * lane + 4 * (j & 1))), gp = *(const f32x4*)(g_pre + (512 * (j >> 1) + 8 * lane + 4 * (j & 1)));
                const f32x4 a = (h[j] * r) * gp * (scl + 1.0f) + sh;
                u32x2 w; w.x = pk2(a.x, a.y); w.y = pk2(a.z, a.w); *(u32x2*)(A + (size_t)row * DM + (512 * (j >> 1) + 8 * lane + 4 * (j & 1))) = w; }
        }
    }
}

template <bool INIT, bool RES, bool NEXT>
__device__ __forceinline__ void rowop(const Params& p, int G, int nrows, float wgt, const float* mod_res, int kgate, const float* g_post,
                                      const float* mod_next, int knext, const float* g_pre) {
    rowop_rows<INIT, RES, NEXT>(p, 0, nrows, bid_opaque() * 8 + (tid_opaque() >> 6), G * 8, wgt, mod_res, kgate, g_post, mod_next, knext, g_pre);
}

template <int NAX> __device__ __forceinline__ void rope_cs(int j, int s, float& cs, float& sn) {
    const int f = j % NAX; const float pos = (float)(j < NAX ? (s >> 6) : (s & 63));
    const float freq = __builtin_amdgcn_exp2f(-13.287712379549449f * (float)f / (float)NAX);
    const float ang = pos * freq; cs = __cosf(ang); sn = __sinf(ang);
}
__device__ __forceinline__ unsigned rope_pair(unsigned w, float cs, float sn) { const float x0 = bflo(w), x1 = bfhi(w); return pk2(x0 * cs - x1 * sn, x0 * sn + x1 * cs); }

__device__ __forceinline__ void post_da(const Params& p, int G) {
    const int lane = tid_opaque() & 63, wid = tid_opaque() >> 6, gw = bid_opaque() * 8 + wid, NGW = G * 8;
    bf16* Q = (bf16*)(p.ws + WS_U);
    for (int row = gw; row < NL; row += NGW) {
        float cs, sn; rope_cs<16>(lane & 31, row & 4095, cs, sn);
        unsigned* rp = (unsigned*)(Q + (size_t)row * 3072) + (lane >> 5) * 32 + (lane & 31);
#pragma unroll 4
        for (int it = 0; it < 16; ++it) rp[it * 64] = rope_pair(rp[it * 64], cs, sn);
    }
}
__device__ __forceinline__ void post_swa(const Params& p, int G) {
    const int lane = tid_opaque() & 63, wid = tid_opaque() >> 6, gw = bid_opaque() * 8 + wid, NGW = G * 8;
    bf16* Q = (bf16*)(p.ws + WS_U);
    for (int row = gw; row < NL; row += NGW) {
        float cs, sn; rope_cs<16>(lane & 31, row & 4095, cs, sn);
        unsigned* rp = (unsigned*)(Q + (size_t)row * 1280) + (lane >> 5) * 32 + (lane & 31);
#pragma unroll 3
        for (int it = 0; it < 9; ++it) rp[it * 64] = rope_pair(rp[it * 64], cs, sn);
    }
}
__device__ __forceinline__ void post_ga(const Params& p, int G) {
    const int lane = tid_opaque() & 63, wid = tid_opaque() >> 6, gw = bid_opaque() * 8 + wid, NGW = G * 8;
    bf16* Q = (bf16*)(p.ws + WS_U);
    const float gq0 = p.ga_q_norm[2 * lane], gq1 = p.ga_q_norm[2 * lane + 1], gk0 = p.ga_k_norm[2 * lane], gk1 = p.ga_k_norm[2 * lane + 1];
    for (int row = gw; row < MT; row += NGW) {
        float cs = 1.f, sn = 0.f; if (row < NL) rope_cs<32>(lane, row & 4095, cs, sn);
        unsigned* rp = (unsigned*)(Q + (size_t)row * 1536) + lane;
#pragma unroll
        for (int s = 8; s < 10; ++s) { const unsigned w = rp[s * 64]; float x0 = bflo(w), x1 = bfhi(w);
            const float r = __builtin_amdgcn_rsqf(wave_sum(x0 * x0 + x1 * x1) * (1.0f / 128.0f) + EPS);
            x0 = x0 * r * (s < 8 ? gq0 : gk0); x1 = x1 * r * (s < 8 ? gq1 : gk1);
            rp[s * 64] = pk2(x0 * cs - x1 * sn, x0 * sn + x1 * cs); }
    }
}
__device__ __forceinline__ void post_mla1(const Params& p, int G) {
    const int lane = tid_opaque() & 63, wid = tid_opaque() >> 6, gw = bid_opaque() * 8 + wid, NGW = G * 8;
    bf16* CIN = (bf16*)(p.ws + WS_CIN); bf16* AQ = (bf16*)(p.ws + WS_AQ); bf16* AKV = (bf16*)(p.ws + WS_AKV);
    const f32x4 gq = *(const f32x4*)(p.mla_q_norm + 4 * lane); const float gk0 = p.mla_kv_norm[2 * lane], gk1 = p.mla_kv_norm[2 * lane + 1];
    for (int row = gw; row < MT; row += NGW) {
        const bf16* cr = CIN + (size_t)row * 512;
        const u32x2 wq = *(const u32x2*)(cr + 4 * lane); const unsigned wk = *(const unsigned*)(cr + 256 + 2 * lane);
        const float q0 = bflo(wq.x), q1 = bfhi(wq.x), q2 = bflo(wq.y), q3 = bfhi(wq.y), k0 = bflo(wk), k1 = bfhi(wk);
        const float rq = __builtin_amdgcn_rsqf(wave_sum((q0 * q0 + q1 * q1) + (q2 * q2 + q3 * q3)) * (1.0f / 256.0f) + EPS);
        const float rk = __builtin_amdgcn_rsqf(wave_sum(k0 * k0 + k1 * k1) * (1.0f / 128.0f) + EPS);
        u32x2 oq; oq.x = pk2(q0 * rq * gq.x, q1 * rq * gq.y); oq.y = pk2(q2 * rq * gq.z, q3 * rq * gq.w);
        *(u32x2*)(AQ + (size_t)row * 256 + 4 * lane) = oq;
        *(unsigned*)(AKV + (size_t)row * 128 + 2 * lane) = pk2(k0 * rk * gk0, k1 * rk * gk1);
        if (row < NL && lane < 16) { float cs, sn; rope_cs<8>(lane, row & 4095, cs, sn);
            unsigned* kp = (unsigned*)(CIN + (size_t)row * 512 + 384) + lane; *kp = rope_pair(*kp, cs, sn); }
    }
}
__device__ __forceinline__ void post_mla2(const Params& p, int G) {
    const int lane = tid_opaque() & 63, wid = tid_opaque() >> 6, gw = bid_opaque() * 8 + wid, NGW = G * 8;
    bf16* Q = (bf16*)(p.ws + WS_MQ);
    for (int row = gw; row < NL; row += NGW) {
        float cs, sn; rope_cs<8>(lane & 15, row & 4095, cs, sn);
#pragma unroll
        for (int it = 0; it < 4; ++it) { const int head = it * 4 + (lane >> 4);
            unsigned* qp = (unsigned*)(Q + (size_t)row * 1536 + head * 96 + 64) + (lane & 15); *qp = rope_pair(*qp, cs, sn); }
    }
}
__device__ __forceinline__ void da_combine(const Params& p, int G, float lambda_init) {
    const int lane = tid_opaque() & 63, wid = tid_opaque() >> 6, gw = bid_opaque() * 8 + wid, NGW = G * 8;
    const bf16* T = (const bf16*)(p.ws + WS_Y); bf16* O = (bf16*)(p.ws + WS_A);
    const float* lm = p.da_lambda;
    const float lam = __expf(wave_sum(lm[lane] * lm[64 + lane])) - __expf(wave_sum(lm[128 + lane] * lm[192 + lane])) + lambda_init;
    const int h = lane >> 3, d0 = (lane & 7) * 16;
    float g[16];
#pragma unroll
    for (int e = 0; e < 16; ++e) g[e] = p.da_subln[d0 + e] * (1.0f - lambda_init);
    for (int row = gw; row < MT; row += NGW) {
        const bf16* t1 = T + (size_t)row * 2048 + h * 256 + d0; const bf16* t2 = t1 + 128;
        const u32x4 a0 = *(const u32x4*)t1, a1 = *(const u32x4*)(t1 + 8), b0 = *(const u32x4*)t2, b1 = *(const u32x4*)(t2 + 8);
        float o[16];
#pragma unroll
        for (int e = 0; e < 4; ++e) { o[2 * e] = bflo(a0[e]) - lam * bflo(b0[e]); o[2 * e + 1] = bfhi(a0[e]) - lam * bfhi(b0[e]);
                                      o[8 + 2 * e] = bflo(a1[e]) - lam * bflo(b1[e]); o[8 + 2 * e + 1] = bfhi(a1[e]) - lam * bfhi(b1[e]); }
        float ss = 0.f;
#pragma unroll
        for (int e = 0; e < 16; ++e) ss += o[e] * o[e];
        ss += __shfl_xor(ss, 1); ss += __shfl_xor(ss, 2); ss += __shfl_xor(ss, 4);
        const float r = __builtin_amdgcn_rsqf(ss * (1.0f / 128.0f) + EPS);
        u32x4 w0, w1;
#pragma unroll
        for (int e = 0; e < 4; ++e) { w0[e] = pk2(o[2 * e] * r * g[2 * e], o[2 * e + 1] * r * g[2 * e + 1]); w1[e] = pk2(o[8 + 2 * e] * r * g[8 + 2 * e], o[8 + 2 * e + 1] * r * g[8 + 2 * e + 1]); }
        bf16* op = O + (size_t)row * DM + h * 128 + d0; *(u32x4*)op = w0; *(u32x4*)(op + 8) = w1;
    }
}

struct AttnDesc {
    const bf16 *Q, *K, *K2, *V; bf16* O; int ldq, ldk, ldk2, ldv, ldo;
    int nh, q_mul, k_off, k_div, k_mul, k2_off, v_off, v_div, v_mul, o_mul; float scale; const float* sink;
    bf16* O2; const float* aux; const float* lam; float lam_init;
};
__device__ __forceinline__ s16x4 vtr(const LAS unsigned char* ptr) { return __builtin_bit_cast(s16x4, __builtin_amdgcn_ds_read_tr16_b64_v4i16((LAS s16x4*)ptr)); }
typedef __bf16 bf16x2_t __attribute__((ext_vector_type(2))); typedef float f32x2_t __attribute__((ext_vector_type(2)));
__device__ __forceinline__ unsigned cvtpk(float lo, float hi) { f32x2_t v = {lo, hi}; bf16x2_t b = __builtin_convertvector(v, bf16x2_t); return __builtin_bit_cast(unsigned, b); }

__device__ __forceinline__ float swapmax(float v) { auto rr = __builtin_amdgcn_permlane32_swap(__float_as_uint(v), __float_as_uint(v), false, false); return fmaxf(__uint_as_float(rr[0]), __uint_as_float(rr[1])); }
__device__ __forceinline__ float swapsum(float v) { auto rr = __builtin_amdgcn_permlane32_swap(__float_as_uint(v), __float_as_uint(v), false, false); return __uint_as_float(rr[0]) + __uint_as_float(rr[1]); }
#define SBAR() __builtin_amdgcn_sched_barrier(0)
#ifndef ATT_DSMASK
#define ATT_DSMASK 0x00F
#endif
#define ATT_DSFENCE() __builtin_amdgcn_sched_barrier(ATT_DSMASK)
template <int DQK, int DK1, int DV, bool SWA, bool DIFF = false>
__device__ __forceinline__ void attn_phase(LAS unsigned char* lds, const AttnDesc d, bool with_ctx, int G) {
    constexpr int KP = DQK * 2 + 16, VP = (DV == 128) ? 320 : 192, KBUF = 64 * KP, VBUF = 64 * VP, BUFB = KBUF + VBUF;
    constexpr int NS = DQK / 16, ND = DV / 32, KCH = DQK / 8, VCH = DV / 8, NKCH = 64 * KCH, NVCH = 64 * VCH, KI = (NKCH + 511) / 512, VI = (NVCH + 511) / 512;
    static_assert(3 * BUFB <= 131072, "attention ring fits the LDS region");
    constexpr bool SD2 = !(DQK == 128 && DV == 128) && !DIFF;
#ifndef ATT_SGB
#define ATT_SGB true
#endif
    constexpr bool SGB = ATT_SGB; constexpr int SGB_TQ = (16 + 2 * NS - 1) / (2 * NS), SGB_VQ = (48 + 2 * NS - 1) / (2 * NS), SGB_VP = (52 + 4 * ND - 1) / (4 * ND);
    constexpr bool QPREP = (DQK == 128 && DV == 128);
    constexpr bool SEQF = (DQK == 128 && DV == 128);
    const int tid = tid_opaque(), lane = tid & 63, wid = __builtin_amdgcn_readfirstlane(tid >> 6), r32 = lane & 31, hi = lane >> 5;
    const float C = d.scale * LOG2E; constexpr float THRS = 8.0f * LOG2E;
    const int n_lat = NB * d.nh * 16, n_units = n_lat + (with_ctx ? NB * d.nh : 0);
    const int bid_ = bid_opaque(), vcu = (G % 8 == 0) ? (bid_ % 8) * (G / 8) + bid_ / 8 : bid_;
    for (int u = vcu; u < n_units; u += G) {
        int b, head, qb; bool isctx;
        if (u < n_lat) { qb = u & 15; head = (u >> 4) % d.nh; b = (u >> 4) / d.nh; isctx = false; }
        else { const int v = u - n_lat; head = v % d.nh; b = v / d.nh; qb = 0; isctx = true; }
        for (int sub = 0; sub < (DIFF ? 2 : 1); ++sub) {
        const int he = DIFF ? head * 2 + sub : head;
        const int qrow_base = (isctx ? NL + b * CTXL : b * SEQ + qb * 256) + wid * 32;
        const int kcol = d.k_off + (he / d.k_div) * d.k_mul, vcol = d.v_off + (he / d.v_div) * d.v_mul;
        int lat_lo = 0, nlt = isctx ? 0 : 64;
        if (SWA) { const int q0 = qb * 256; lat_lo = q0 - 128 < 0 ? 0 : q0 - 128; const int lat_hi = q0 + 384 > SEQ ? SEQ : q0 + 384; nlt = (lat_hi - lat_lo) >> 6; }
        const int NT = 4 + nlt;
        const int ctx_row0 = NL + b * CTXL, lat_row0 = b * SEQ + lat_lo;
        const int qpos = qb * 256 + wid * 32 + r32;
        bf16x8 qf[NS];
        { int lq_ = lane; asm volatile("" : "+v"(lq_)); const bf16* qp = d.Q + (size_t)(qrow_base + (lq_ & 31)) * d.ldq + he * d.q_mul + (lq_ >> 5) * 8;
#pragma unroll
          for (int s = 0; s < NS; ++s) qf[s] = *(const bf16x8*)(qp + s * 16); }
        if (QPREP) {
            float ssq = 0.f;
#pragma unroll
            for (int s = 0; s < NS; ++s)
#pragma unroll
                for (int e = 0; e < 8; ++e) { const float v = __uint_as_float((unsigned)(unsigned short)qf[s][e] << 16); ssq += v * v; }
            ssq = swapsum(ssq);
            const float rq = __builtin_amdgcn_rsqf(ssq * (1.0f / 128.0f) + EPS);
            int lh_ = lane; asm volatile("" : "+v"(lh_)); const int hq = lh_ >> 5, rq32 = lh_ & 31;
            const int sp_ = (qrow_base + rq32) & 4095; const float prow = (float)(sp_ >> 6), pcol = (float)(sp_ & 63);
#pragma unroll
            for (int s = 0; s < NS; ++s) {
                const f32x4 g0 = *(const f32x4*)(d.aux + s * 16 + hq * 8), g1 = *(const f32x4*)(d.aux + s * 16 + hq * 8 + 4);
                float x[8];
#pragma unroll
                for (int e = 0; e < 8; ++e) x[e] = __uint_as_float((unsigned)(unsigned short)qf[s][e] << 16) * rq * (e < 4 ? g0[e] : g1[e - 4]);
                if (!isctx) {
#pragma unroll
                    for (int pr = 0; pr < 4; ++pr) { const int j = s * 8 + hq * 4 + pr;
                        const float freq = __builtin_amdgcn_exp2f(-13.287712379549449f * (float)(j & 31) * (1.0f / 32.0f)); const float ang = (s < 4 ? prow : pcol) * freq;
                        const float cs = __cosf(ang), sn = __sinf(ang), a = x[2 * pr], b2 = x[2 * pr + 1]; x[2 * pr] = a * cs - b2 * sn; x[2 * pr + 1] = a * sn + b2 * cs; } }
                u32x4 w; w.x = cvtpk(x[0], x[1]); w.y = cvtpk(x[2], x[3]); w.z = cvtpk(x[4], x[5]); w.w = cvtpk(x[6], x[7]); qf[s] = __builtin_bit_cast(bf16x8, w);
            }
        }
        u32x4 kreg0[KI], vreg0[VI], kreg1[KI], vreg1[VI];
    constexpr bool K2S = (DK1 != DQK); constexpr int KCHA = K2S ? DK1 / 8 : KCH, KCHB = K2S ? (DQK - DK1) / 8 : 1, KRP = 512 / KCHA, VRP = 512 / VCH;
    static_assert(512 % KCHA == 0 && 512 % VCH == 0 && (!K2S || (64 * KCHA == 512 && 64 * KCHB <= 512 && KI == 2)), "staging map");
    constexpr bool HOIST = true;
    unsigned h_vgo = 0, h_kgo = 0, h_kgoB = 0, h_vlo = 0, h_klo = 0, h_kloB = 0;
    if (HOIST) { h_vgo = (unsigned)((tid / VCH) * d.ldv + (tid % VCH) * 8) * 2u; h_kgo = (unsigned)((tid / KCHA) * d.ldk + (tid % KCHA) * 8) * 2u; h_kgoB = K2S ? (unsigned)((tid / KCHB) * d.ldk2 + (tid % KCHB) * 8) * 2u : 0u;
        h_vlo = (unsigned)((tid / VCH) * VP + (tid % VCH) * 16); h_klo = (unsigned)((tid / KCHA) * KP + (tid % KCHA) * 16); h_kloB = K2S ? (unsigned)((tid / KCHB) * KP + DK1 * 2 + (tid % KCHB) * 16) : 0u; }
#define ATT_GOFF() unsigned vgo, kgo, kgoB; if (HOIST) { vgo = h_vgo; kgo = h_kgo; kgoB = h_kgoB; } else { int t2_ = tid; asm volatile("" : "+v"(t2_)); \
            vgo = (unsigned)((t2_ / VCH) * d.ldv + (t2_ % VCH) * 8) * 2u; kgo = (unsigned)((t2_ / KCHA) * d.ldk + (t2_ % KCHA) * 8) * 2u; kgoB = K2S ? (unsigned)((t2_ / KCHB) * d.ldk2 + (t2_ % KCHB) * 8) * 2u : 0u; } (void)kgoB
#define ATT_LOFF() unsigned vlo, klo, kloB; if (HOIST) { vlo = h_vlo; klo = h_klo; kloB = h_kloB; } else { int t3_ = tid; asm volatile("" : "+v"(t3_)); \
            vlo = (unsigned)((t3_ / VCH) * VP + (t3_ % VCH) * 16); klo = (unsigned)((t3_ / KCHA) * KP + (t3_ % KCHA) * 16); kloB = K2S ? (unsigned)((t3_ / KCHB) * KP + DK1 * 2 + (t3_ % KCHB) * 16) : 0u; } (void)kloB
#define ATT_LOAD(t_, kreg, vreg) ATT_LOADX(t_, kreg, vreg, ctx_row0, lat_row0, kcol, vcol)
#define ATT_LOADX(t_, kreg, vreg, ctx_row0, lat_row0, kcol, vcol) do { ATT_GOFF(); const int krow0_ = (t_) < 4 ? ctx_row0 + (t_) * 64 : lat_row0 + ((t_) - 4) * 64; \
            if (!K2S) { _Pragma("unroll") for (int i_ = 0; i_ < KI; ++i_) { const char* kb_ = (const char*)(d.K + (size_t)(krow0_ + i_ * KRP) * d.ldk + kcol); kreg[i_] = *(const u32x4*)(kb_ + kgo); } } \
            else { kreg[0] = *(const u32x4*)((const char*)(d.K + (size_t)krow0_ * d.ldk + kcol) + kgo); \
                   if (tid < 64 * KCHB) kreg[1] = *(const u32x4*)((const char*)(d.K2 + (size_t)krow0_ * d.ldk2 + d.k2_off) + kgoB); } \
            _Pragma("unroll") for (int i_ = 0; i_ < VI; ++i_) { const char* vb_ = (const char*)(d.V + (size_t)(krow0_ + i_ * VRP) * d.ldv + vcol); vreg[i_] = *(const u32x4*)(vb_ + vgo); } } while (0)
#define ATT_STORE(boff_, kreg, vreg) do { ATT_LOFF(); LAS unsigned char* kb_ = lds + (boff_); \
            if (!K2S) { _Pragma("unroll") for (int i_ = 0; i_ < KI; ++i_) *(LAS u32x4*)(kb_ + i_ * KRP * KP + klo) = kreg[i_]; } \
            else { *(LAS u32x4*)(kb_ + klo) = kreg[0]; if (tid < 64 * KCHB) *(LAS u32x4*)(kb_ + kloB) = kreg[1]; } \
            _Pragma("unroll") for (int i_ = 0; i_ < VI; ++i_) *(LAS u32x4*)(kb_ + KBUF + i_ * VRP * VP + vlo) = vreg[i_]; } while (0)
#define ATT_QKT(P0, P1, boff_) do { const LAS unsigned char* kb_ = lds + (boff_) + r32 * KP + hi * 16; P0 = f32x16{}; P1 = f32x16{}; __builtin_amdgcn_s_setprio(1); \
            _Pragma("unroll") for (int s_ = 0; s_ < NS; ++s_) { const bf16x8 k0_ = *(const LAS bf16x8*)(kb_ + s_ * 32), k1_ = *(const LAS bf16x8*)(kb_ + 32 * KP + s_ * 32); \
                P0 = __builtin_amdgcn_mfma_f32_32x32x16_bf16(k0_, qf[s_], P0, 0, 0, 0); P1 = __builtin_amdgcn_mfma_f32_32x32x16_bf16(k1_, qf[s_], P1, 0, 0, 0); if (s_ & 1) ATT_DSFENCE(); } __builtin_amdgcn_s_setprio(0); } while (0)
#define ATT_MASK(P0, P1, t_) do { \
            if (SWA && (t_) >= 4) { const int kt_ = lat_lo + ((t_) - 4) * 64, qw_ = qb * 256 + wid * 32;     \
                if (kt_ < qw_ - 97 || kt_ > qw_ + 65) {                                                      \
                    if (kt_ > qw_ + 159 || kt_ + 63 < qw_ - 128) { _Pragma("unroll") for (int i_ = 0; i_ < 16; ++i_) { P0[i_] = -1e30f; P1[i_] = -1e30f; } }     \
                    else { const int kp0_ = kt_ + 4 * hi; \
                        _Pragma("unroll") for (int i_ = 0; i_ < 16; ++i_) { const int kp_ = kp0_ + (i_ & 3) + 8 * (i_ >> 2); int dd_ = qpos - kp_; dd_ = dd_ < 0 ? -dd_ : dd_; if (dd_ > 128) P0[i_] = -1e30f; \
                            int d2_ = qpos - kp_ - 32; d2_ = d2_ < 0 ? -d2_ : d2_; if (d2_ > 128) P1[i_] = -1e30f; } } } } } while (0)
          \
#define ATT_PARTIAL0(P0, P1, AL) do { \
            float pm_ = fmaxf(P0[0], P1[0]); \
            _Pragma("unroll") for (int i_ = 1; i_ < 16; ++i_) pm_ = fmaxf(pm_, fmaxf(P0[i_], P1[i_])); \
            pm_ = swapmax(pm_); ms = pm_ * C; AL = 0.f; const float mc_ = -ms; \
            _Pragma("unroll") for (int i_ = 0; i_ < 16; ++i_) { P0[i_] = fmaf(P0[i_], C, mc_); P1[i_] = fmaf(P1[i_], C, mc_); } \
            _Pragma("unroll") for (int i_ = 0; i_ < 16; ++i_) P0[i_] = __builtin_amdgcn_exp2f(P0[i_]); } while (0)
          \
#define ATT_PARTIAL(P0, P1, t_, AL) do { ATT_MASK(P0, P1, t_); \
            const float mc_ = -ms; \
            _Pragma("unroll") for (int i_ = 0; i_ < 16; ++i_) { P0[i_] = fmaf(P0[i_], C, mc_); P1[i_] = fmaf(P1[i_], C, mc_); } \
            float pa_ = fmaxf(fmaxf(P0[0], P1[0]), P0[1]), pb_ = fmaxf(fmaxf(P1[1], P0[2]), P1[2]); \
            _Pragma("unroll") for (int i_ = 3; i_ < 15; i_ += 2) { pa_ = fmaxf(fmaxf(pa_, P0[i_]), P1[i_]); pb_ = fmaxf(fmaxf(pb_, P0[i_ + 1]), P1[i_ + 1]); } \
            float pm_ = fmaxf(fmaxf(pa_, P0[15]), fmaxf(pb_, P1[15])); \
            pm_ = swapmax(pm_); if (SGB) ATT_SGB_PP(); \
            if (__builtin_expect(__all(pm_ <= THRS), 1)) { AL = 1.f; } \
            else { const float dl_ = fmaxf(pm_, 0.f); ms += dl_; AL = __builtin_amdgcn_exp2f(-dl_); \
                _Pragma("unroll") for (int i_ = 0; i_ < 16; ++i_) { P0[i_] -= dl_; P1[i_] -= dl_; } } \
            _Pragma("unroll") for (int i_ = 0; i_ < 16; ++i_) P0[i_] = __builtin_amdgcn_exp2f(P0[i_]); } while (0)
#define ATT_FINISH(P0, P1, AL) do { \
            _Pragma("unroll") for (int i_ = 0; i_ < 16; ++i_) P1[i_] = __builtin_amdgcn_exp2f(P1[i_]); \
            float ps_ = 0.f; \
            _Pragma("unroll") for (int i_ = 0; i_ < 16; ++i_) ps_ += P0[i_] + P1[i_]; \
            l = l * AL + ps_; u32x4 w_; \
            w_.x = cvtpk(P0[0], P0[1]); w_.y = cvtpk(P0[2], P0[3]); w_.z = cvtpk(P0[4], P0[5]); w_.w = cvtpk(P0[6], P0[7]); pf[0] = __builtin_bit_cast(bf16x8, w_); \
            w_.x = cvtpk(P0[8], P0[9]); w_.y = cvtpk(P0[10], P0[11]); w_.z = cvtpk(P0[12], P0[13]); w_.w = cvtpk(P0[14], P0[15]); pf[1] = __builtin_bit_cast(bf16x8, w_); \
            w_.x = cvtpk(P1[0], P1[1]); w_.y = cvtpk(P1[2], P1[3]); w_.z = cvtpk(P1[4], P1[5]); w_.w = cvtpk(P1[6], P1[7]); pf[2] = __builtin_bit_cast(bf16x8, w_); \
            w_.x = cvtpk(P1[8], P1[9]); w_.y = cvtpk(P1[10], P1[11]); w_.z = cvtpk(P1[12], P1[13]); w_.w = cvtpk(P1[14], P1[15]); pf[3] = __builtin_bit_cast(bf16x8, w_); } while (0)
#define ATT_PV(boff_) do { __builtin_amdgcn_s_setprio(1); const LAS unsigned char* vb_ = lds + (boff_) + KBUF + (4 * hi + ((lane & 15) >> 2)) * VP + (16 * ((lane >> 4) & 1) + 4 * (lane & 3)) * 2; \
            _Pragma("unroll") for (int db_ = 0; db_ < ND; ++db_) _Pragma("unroll") for (int ks_ = 0; ks_ < 4; ++ks_) { \
                const s16x4 lo_ = vtr(vb_ + (16 * ks_) * VP + db_ * 64), up_ = vtr(vb_ + (16 * ks_ + 8) * VP + db_ * 64); \
                const bf16x8 vf_ = (bf16x8){lo_[0], lo_[1], lo_[2], lo_[3], up_[0], up_[1], up_[2], up_[3]}; \
                o[db_] = __builtin_amdgcn_mfma_f32_32x32x16_bf16(vf_, pf[ks_], o[db_], 0, 0, 0); if (ks_ & 1) ATT_DSFENCE(); } __builtin_amdgcn_s_setprio(0); } while (0)
#define ATT_SGB_QF() do { _Pragma("unroll") for (int g_ = 0; g_ < 2 * NS; ++g_) { __builtin_amdgcn_sched_group_barrier(0x008, 1, 0); __builtin_amdgcn_sched_group_barrier(0x100, 1, 0); \
            __builtin_amdgcn_sched_group_barrier(0x400, SGB_TQ, 0); __builtin_amdgcn_sched_group_barrier(0x002, SGB_VQ, 0); } } while (0)
#define ATT_SGB_PP() do { _Pragma("unroll") for (int g_ = 0; g_ < 4 * ND; ++g_) { __builtin_amdgcn_sched_group_barrier(0x008, 1, 0); __builtin_amdgcn_sched_group_barrier(0x100, 2, 0); \
            __builtin_amdgcn_sched_group_barrier(0x002, SGB_VP, 0); } } while (0)
#define ATT_OUT(j_) (SWA && (j_) >= 4 && ((lat_lo + ((j_) - 4) * 64) > (qb * 256 + wid * 32) + 159 || (lat_lo + ((j_) - 4) * 64) + 63 < (qb * 256 + wid * 32) - 128))
#define ATT_STEP(C0, C1, ALC, SKC, N0, N1, ALN, SKN, j_, KL, VL, KS, VS) do { SBAR(); if (SD2) { if ((j_) + 2 < NT) ATT_LOAD((j_) + 2, KL, VL); } else { if ((j_) + 1 < NT) ATT_LOAD((j_) + 1, kreg0, vreg0); } SBAR(); \
            SKN = ATT_OUT(j_); \
            if (SEQF) { if (!SKC) ATT_FINISH(C0, C1, ALC); SBAR(); if (!SKN) ATT_QKT(N0, N1, bo_cur); } else { if (!SKN) ATT_QKT(N0, N1, bo_cur); if (!SKC) ATT_FINISH(C0, C1, ALC); if (SGB) ATT_SGB_QF(); } SBAR(); \
            if (!SKC) ATT_PV(bo_prev); if (!SKN) ATT_PARTIAL(N0, N1, j_, ALN); else ALN = 1.f; \
            if ((j_) + 1 < NT) { if (SD2) ATT_STORE(bo_next, KS, VS); else ATT_STORE(bo_next, kreg0, vreg0); } \
            if (__any(ALN < 1.f)) { _Pragma("unroll") for (int i_ = 0; i_ < ND; ++i_) o[i_] *= ALN; } \
            __syncthreads(); { const int t_ = bo_prev; bo_prev = bo_cur; bo_cur = bo_next; bo_next = t_; } } while (0)
        float ms = 0.f, l = 0.f; bool skA = false, skB = false;
        f32x16 o[ND];
#pragma unroll
        for (int i = 0; i < ND; ++i) o[i] = f32x16{};
        f32x16 pA0, pA1, pB0, pB1; float alA = 1.f, alB = 1.f; bf16x8 pf[4];
        int bo_prev = 0, bo_cur = BUFB, bo_next = 2 * BUFB;
        ATT_LOAD(0, kreg0, vreg0); ATT_STORE(0, kreg0, vreg0);
        __syncthreads();
        ATT_QKT(pA0, pA1, 0); ATT_PARTIAL0(pA0, pA1, alA);
        if (SD2) { ATT_LOAD(1, kreg1, vreg1); ATT_STORE(BUFB, kreg1, vreg1); } else { ATT_LOAD(1, kreg0, vreg0); ATT_STORE(BUFB, kreg0, vreg0); }
        if (SD2) ATT_LOAD(2, kreg0, vreg0);
        __syncthreads();
        for (int j = 1; j + 1 < NT; j += 2) {
            ATT_STEP(pA0, pA1, alA, skA, pB0, pB1, alB, skB, j, kreg1, vreg1, kreg0, vreg0);
            ATT_STEP(pB0, pB1, alB, skB, pA0, pA1, alA, skA, j + 1, kreg0, vreg0, kreg1, vreg1);
        }
        ATT_STEP(pA0, pA1, alA, skA, pB0, pB1, alB, skB, NT - 1, kreg1, vreg1, kreg0, vreg0);
        if (!skB) { ATT_FINISH(pB0, pB1, alB); SBAR();
        ATT_PV(bo_prev); }
#undef ATT_LOAD
#undef ATT_STORE
#undef ATT_QKT
#undef ATT_PARTIAL
#undef ATT_PARTIAL0
#undef ATT_MASK
#undef ATT_FINISH
#undef ATT_PV
#undef ATT_STEP
#undef ATT_OUT
        l = swapsum(l);
        if (SWA) l += __builtin_amdgcn_exp2f(d.sink[head] * LOG2E - ms);
        const float inv = __builtin_amdgcn_rcpf(l);
        int lo_ = lane; asm volatile("" : "+v"(lo_));
        bf16* op = d.O + (size_t)(qrow_base + (lo_ & 31)) * d.ldo + he * d.o_mul + 4 * (lo_ >> 5);
        if (!DIFF || sub == 0) {
            bf16* opw = op + 4 * (lo_ >> 5);
#pragma unroll
            for (int db = 0; db < ND; ++db)
#pragma unroll
                for (int g = 0; g < 4; g += 2) {
                    const unsigned ax = cvtpk(o[db][4 * g] * inv, o[db][4 * g + 1] * inv), ay = cvtpk(o[db][4 * g + 2] * inv, o[db][4 * g + 3] * inv);
                    const unsigned bx = cvtpk(o[db][4 * g + 4] * inv, o[db][4 * g + 5] * inv), by = cvtpk(o[db][4 * g + 6] * inv, o[db][4 * g + 7] * inv);
                    const auto r0 = __builtin_amdgcn_permlane32_swap(ax, bx, false, false); const auto r1 = __builtin_amdgcn_permlane32_swap(ay, by, false, false);
                    u32x4 w; w.x = r0[0]; w.y = r1[0]; w.z = r0[1]; w.w = r1[1];
                    *(u32x4*)(opw + db * 32 + 8 * g) = w; }
        } else {
            const float* lm = d.lam;
            const float lamv = __expf(wave_sum(lm[lo_] * lm[64 + lo_])) - __expf(wave_sum(lm[128 + lo_] * lm[192 + lo_])) + d.lam_init;
            const bf16* tpw = op - d.o_mul + 4 * (lo_ >> 5); float ss = 0.f;
#pragma unroll
            for (int db = 0; db < ND; ++db)
#pragma unroll
                for (int g = 0; g < 4; g += 2) { const u32x4 L = *(const u32x4*)(tpw + db * 32 + 8 * g);
                    const auto r0 = __builtin_amdgcn_permlane32_swap(L.x, L.z, false, false); const auto r1 = __builtin_amdgcn_permlane32_swap(L.y, L.w, false, false);
                    const unsigned wa_x = r0[0], wa_y = r1[0], wb_x = r0[1], wb_y = r1[1];
                    { const float v0 = bflo(wa_x) - lamv * (o[db][4 * g] * inv), v1 = bfhi(wa_x) - lamv * (o[db][4 * g + 1] * inv), v2 = bflo(wa_y) - lamv * (o[db][4 * g + 2] * inv), v3 = bfhi(wa_y) - lamv * (o[db][4 * g + 3] * inv);
                      o[db][4 * g] = v0; o[db][4 * g + 1] = v1; o[db][4 * g + 2] = v2; o[db][4 * g + 3] = v3; ss += (v0 * v0 + v1 * v1) + (v2 * v2 + v3 * v3); }
                    { const float v0 = bflo(wb_x) - lamv * (o[db][4 * g + 4] * inv), v1 = bfhi(wb_x) - lamv * (o[db][4 * g + 5] * inv), v2 = bflo(wb_y) - lamv * (o[db][4 * g + 6] * inv), v3 = bfhi(wb_y) - lamv * (o[db][4 * g + 7] * inv);
                      o[db][4 * g + 4] = v0; o[db][4 * g + 5] = v1; o[db][4 * g + 6] = v2; o[db][4 * g + 7] = v3; ss += (v0 * v0 + v1 * v1) + (v2 * v2 + v3 * v3); } }
            ss = swapsum(ss);
            const float rn = __builtin_amdgcn_rsqf(ss * (1.0f / 128.0f) + EPS) * (1.0f - d.lam_init);
            bf16* op2 = d.O2 + (size_t)(qrow_base + (lo_ & 31)) * DM + head * 128 + 4 * (lo_ >> 5);
            bf16* op2w = op2 + 4 * (lo_ >> 5);
#pragma unroll
            for (int db = 0; db < ND; ++db)
#pragma unroll
                for (int g = 0; g < 4; g += 2) { const f32x4 ga = *(const f32x4*)(d.aux + db * 32 + 8 * g + 4 * (lo_ >> 5)), gb = *(const f32x4*)(d.aux + db * 32 + 8 * g + 8 + 4 * (lo_ >> 5));
                    const unsigned ax = cvtpk(o[db][4 * g] * rn * ga.x, o[db][4 * g + 1] * rn * ga.y), ay = cvtpk(o[db][4 * g + 2] * rn * ga.z, o[db][4 * g + 3] * rn * ga.w);
                    const unsigned bx = cvtpk(o[db][4 * g + 4] * rn * gb.x, o[db][4 * g + 5] * rn * gb.y), by = cvtpk(o[db][4 * g + 6] * rn * gb.z, o[db][4 * g + 7] * rn * gb.w);
                    const auto r0 = __builtin_amdgcn_permlane32_swap(ax, bx, false, false); const auto r1 = __builtin_amdgcn_permlane32_swap(ay, by, false, false);
                    u32x4 w; w.x = r0[0]; w.y = r1[0]; w.z = r0[1]; w.w = r1[1];
                    *(u32x4*)(op2w + db * 32 + 8 * g) = w; }
        }
        asm volatile("s_waitcnt lgkmcnt(0)\n\ts_barrier" ::: "memory");
        }
    }
}

typedef __attribute__((address_space(1))) unsigned gu32;
#define XB_TMO      128
#define XB_XCNT(j)  (256  + 64 * (j))
#define XB_XSUB(j)  (1280 + 64 * (j))
#define XB_XGEN(j)  (2304 + 64 * (j))
#define XB_TOP      3328
#define XB_TOPGEN   3392
#define XCD_BAR_WORDS 3456
#define XB_SPIN_CAP (1u << 18)

__device__ __forceinline__ unsigned xb_ld(unsigned* p)              { return __hip_atomic_load(p, __ATOMIC_RELAXED, __HIP_MEMORY_SCOPE_AGENT); }
__device__ __forceinline__ unsigned xb_add(unsigned* p, unsigned v) { return __hip_atomic_fetch_add(p, v, __ATOMIC_RELAXED, __HIP_MEMORY_SCOPE_AGENT); }
__device__ __forceinline__ unsigned xb_xcc_id() { return (unsigned)__builtin_amdgcn_s_getreg((3 << 11) | 20) & 0xFu; }
#define XB_SPIN(cond, bar) do { unsigned _sp = 0; while (cond) { __builtin_amdgcn_s_sleep(1); \
    if ((++_sp & 255u) == 0u) { if (xb_ld(&(bar)[XB_TMO])) break; if (_sp > XB_SPIN_CAP) { atomicAdd(&(bar)[XB_TMO], 1u); break; } } } } while (0)

struct XcdBarrier {
    unsigned* bar; unsigned x;
    volatile LAS unsigned* st;
};

__device__ __forceinline__ XcdBarrier xcd_barrier_post(unsigned* bar, volatile LAS unsigned* st) {
    XcdBarrier b; b.bar = bar; b.x = xb_xcc_id(); b.st = st;
    if (threadIdx.x == 0) (void)xb_add(&bar[XB_XCNT(b.x)], 1u);
    return b;
}
__device__ __forceinline__ void xcd_barrier_complete(unsigned* bar, unsigned x, unsigned& nloc, unsigned& nx) {
    const unsigned G = gridDim.x * gridDim.y * gridDim.z;
    unsigned sum, cnt, mine, sp = 0u;
    for (;;) {
        sum = 0u; cnt = 0u; mine = 0u;
#pragma unroll
        for (unsigned j = 0; j < 16; ++j) { const unsigned c = xb_ld(&bar[XB_XCNT(j)]); sum += c; cnt += (c > 0u) ? 1u : 0u; mine = (j == x) ? c : mine; }
        if (sum == G) break;
        __builtin_amdgcn_s_sleep(1);
        if ((++sp & 255u) == 0u) { if (xb_ld(&bar[XB_TMO])) break; if (sp > XB_SPIN_CAP) { atomicAdd(&bar[XB_TMO], 1u); break; } }
    }
    nloc = mine > 0u ? mine : 1u; nx = cnt > 0u ? cnt : 1u;
}

__device__ __forceinline__ void xcd_barrier(const XcdBarrier& b) {
    asm volatile("s_waitcnt vmcnt(0)" ::: "memory");
    __syncthreads();
    if (threadIdx.x == 0) {
        unsigned* bar = b.bar;
        __builtin_amdgcn_s_waitcnt(0);
        unsigned nloc = b.st[0], nx = b.st[1];
        if (nloc == 0u) { xcd_barrier_complete(bar, b.x, nloc, nx); b.st[0] = nloc; b.st[1] = nx; }
        const unsigned old = xb_add(&bar[XB_XSUB(b.x)], 1u);
        const unsigned gen = old / nloc;
        if (old + 1u == (gen + 1u) * nloc) {
            __builtin_amdgcn_fence(__ATOMIC_RELEASE, "agent");
            asm volatile("s_waitcnt vmcnt(0)" ::: "memory");
            const unsigned og = xb_add(&bar[XB_TOP], 1u);
            const unsigned tg = og / nx;
            if (og + 1u == (tg + 1u) * nx) xb_add(&bar[XB_TOPGEN], 1u);
            else XB_SPIN(xb_ld(&bar[XB_TOPGEN]) == tg, bar);
            __builtin_amdgcn_fence(__ATOMIC_ACQUIRE, "agent");
            xb_add(&bar[XB_XGEN(b.x)], 1u);
            asm volatile("s_waitcnt vmcnt(0)" ::: "memory");
        } else {
            XB_SPIN(xb_ld(&bar[XB_XGEN(b.x)]) == gen, bar);
            __builtin_amdgcn_fence(__ATOMIC_ACQUIRE, "agent");
            asm volatile("s_waitcnt vmcnt(0)" ::: "memory");
        }
    }
    __syncthreads();
}

#ifndef GALIGN
#define GALIGN true
#endif
#ifndef GSP2
#define GSP2 true
#endif
template <class T> __device__ __forceinline__ T* uptr(T* q) {
    const unsigned long long v = (unsigned long long)q; const unsigned lo = __builtin_amdgcn_readfirstlane((unsigned)v), hi = __builtin_amdgcn_readfirstlane((unsigned)(v >> 32));
    return (T*)(__attribute__((address_space(1))) T*)(((unsigned long long)hi << 32) | lo); }
#define LOADP() Params p; { auto q_ = __builtin_amdgcn_kernarg_segment_ptr(); asm volatile("" : "+s"(q_)); __builtin_memcpy(&p, (const void*)q_, sizeof(Params)); } \
    unsigned char* const ws = uptr(p.ws); const int G = gridDim.x; (void)ws; (void)G
#define GSYNC_CG() cg::this_grid().sync()
#define GSYNC() do { LOADP(); XcdBarrier b_; b_.bar = (unsigned*)(ws + WS_BAR); b_.x = xb_xcc_id(); b_.st = (volatile LAS unsigned*)(lds + 131072 + 32); xcd_barrier(b_); } while (0)
__global__ void __launch_bounds__(NTHREADS, 2) fwd_megakernel(Params p_unused) {
    extern __shared__ __attribute__((aligned(16))) unsigned char lds_raw[];
    LAS unsigned char* lds = (LAS unsigned char*)lds_raw;
    if (tid_opaque() < 16) ((LAS unsigned*)(lds + 131072))[tid_opaque()] = 0u;
    __syncthreads();
    { LOADP(); (void)xcd_barrier_post((unsigned*)(ws + WS_BAR), (volatile LAS unsigned*)(lds + 131072 + 32)); }
#ifndef NO_P0
    { LOADP(); phase0(p, lds, G); }
#endif
    GSYNC_CG();
    { LOADP(); phase0b(p, G); }
    GSYNC();
    { LOADP(); rowop<true, false, true>(p, G, MT, 0.f, nullptr, 0, nullptr, (const float*)(ws + WS_MOD), 0, p.norm_g); }
    GSYNC();

#pragma unroll 1
    for (int layer = 0; layer < 4; ++layer) {
#pragma unroll 1
        for (int half = 0; half < 2; ++half) {
            if (half == 1) {
                const int nsteps = layer == 2 ? 3 : 1;
#pragma unroll 1
                for (int s = 0; s < nsteps; ++s) {
#ifndef NO_G3
                    { LOADP(); bf16* A = (bf16*)(ws + WS_A); bf16* U = (bf16*)(ws + WS_U);
                      pg8::Gemm g; pg8::EpiBf16Rope E;
                      if (layer == 0)      { g = pg8::Gemm{A, (const bf16*)(ws + WS_DA_IN), MT, 3072, 1024}; E = pg8::EpiBf16Rope{U, 3072, 1, 2048, NL / 256}; }
                      else if (layer == 1) { g = pg8::Gemm{A, (const bf16*)(ws + WS_GA_IN), MT, 1536, 1024}; E = pg8::EpiBf16Rope{U, 1536, 0, 0, 0}; }
                      else if (layer == 3) { g = pg8::Gemm{A, (const bf16*)(ws + WS_SWA_IN), MT, 1280, 1024}; E = pg8::EpiBf16Rope{U, 1280, 1, 1152, NL / 256}; }
                      else if (s == 0)     { g = pg8::Gemm{A, (const bf16*)(ws + WS_MLA_IN), MT, 512, 1024}; E = pg8::EpiBf16Rope{(bf16*)(ws + WS_CIN), 512, 0, 0, 0}; }
                      else if (s == 1)     { g = pg8::Gemm{(const bf16*)(ws + WS_AQ), (const bf16*)(ws + WS_MLA_UQ), MT, 1536, 256}; E = pg8::EpiBf16Rope{(bf16*)(ws + WS_MQ), 1536, 2, 0, NL / 256}; }
                      else                 { g = pg8::Gemm{(const bf16*)(ws + WS_AKV), (const bf16*)(ws + WS_MLA_UKV), MT, 2048, 128};     E = pg8::EpiBf16Rope{(bf16*)(ws + WS_MKV), 2048, 0, 0, 0}; }
                      pg8::StaticOrder S; S.init(g.M, g.N, G, (int)bid_opaque());
                      pg8::gemm_phase<pg8::EpiBf16Rope, pg8::StaticOrder, GALIGN, GSP2>(lds, g, S, E); }
#endif
                    if (layer == 2 && s == 1) continue;
                    GSYNC();
                    if (layer == 1 || (layer == 2 && s == 0)) {
                        { LOADP();
                          if (layer == 1) post_ga(p, G);
                          else post_mla1(p, G); }
                        GSYNC();
                    }
                }
                if (layer == 0) {
#ifndef NO_ATT0
                    { LOADP(); const bf16* U = (const bf16*)(ws + WS_U);
                      AttnDesc d{U, U, U, U, (bf16*)(ws + WS_Y), 3072, 3072, 0, 3072, 2048, 8, 64, 1024, 1, 64, 0, 2048, 2, 128, 128, 0.125f, nullptr, (bf16*)(ws + WS_A), uptr(p.da_subln), uptr(p.da_lambda), 0.8f - 0.6f};
                      attn_phase<64, 64, 128, false, true>(lds, d, true, G); }
#endif
                } else if (layer == 1) {
#ifndef NO_ATT1
                    { LOADP(); const bf16* U = (const bf16*)(ws + WS_U);
                      AttnDesc d{U, U, U, U, (bf16*)(ws + WS_A), 1536, 1536, 0, 1536, 1024, 8, 128, 1024, 4, 128, 0, 1280, 4, 128, 128, 0.08838834764831845f, nullptr, nullptr, uptr(p.ga_q_norm), nullptr, 0.f};
                      attn_phase<128, 128, 128, false>(lds, d, true, G); }
#endif
                } else if (layer == 2) {
#ifndef NO_ATT2
                    { LOADP(); const bf16* q = (const bf16*)(ws + WS_MQ); const bf16* kv = (const bf16*)(ws + WS_MKV);
                      AttnDesc d{q, kv, (const bf16*)(ws + WS_CIN), kv, (bf16*)(ws + WS_A), 1536, 2048, 512, 2048, 1024, 16, 96, 0, 1, 128, 384, 64, 1, 128, 64, 0.10206207261596575f, nullptr};
                      attn_phase<96, 64, 64, false>(lds, d, true, G); }
#endif
                } else {
#ifndef NO_ATT3
                    { LOADP(); const bf16* U = (const bf16*)(ws + WS_U);
                      AttnDesc d{U, U, U, U, (bf16*)(ws + WS_A), 1280, 1280, 0, 1280, 1024, 16, 64, 1024, 8, 64, 0, 1152, 8, 64, 64, 0.125f, p.swa_sink};
                      attn_phase<64, 64, 64, true>(lds, d, false, G); }
#endif
                }
                GSYNC();
#ifndef NO_G4
                { LOADP();
                  const size_t wo = layer == 0 ? WS_DA_OUT : layer == 1 ? WS_GA_OUT : layer == 2 ? WS_MLA_OUT : WS_SWA_OUT;
                  pg8::Gemm g{(const bf16*)(ws + WS_A), (const bf16*)(ws + wo), layer < 3 ? MT : NL, 1024, 1024}; pg8::EpiBf16S E{(bf16*)(ws + WS_Y), 1024};
                  pg8::StaticOrder S; S.init(g.M, g.N, G, (int)bid_opaque());
                  pg8::gemm_phase<pg8::EpiBf16S, pg8::StaticOrder, GALIGN, GSP2>(lds, g, S, E); }
#endif
                GSYNC();
                { LOADP(); const float* gl = p.norm_g + (size_t)layer * 6 * DM; const float* modl = (const float*)(ws + WS_MOD) + (size_t)layer * 9 * NMOD;
                  rowop<false, true, true>(p, G, layer < 3 ? MT : NL, 1.0f, modl, 5, gl + 3 * DM, modl, 6, gl + 4 * DM); }
                GSYNC();
            }
#ifndef NO_G1
            { LOADP();
              pg8::Gemm g{(const bf16*)(ws + WS_A), (const bf16*)(ws + WS_FIN + (size_t)(layer * 2 + half) * FIN_BYTES), (half == 0 || layer < 3) ? MT : NL, 2 * DFF, 1024}; pg8::EpiSwiGLU E{(bf16*)(ws + WS_U), DFF};
              pg8::StaticOrder S; S.init(g.M, g.N, G, (int)bid_opaque());
              pg8::gemm_phase<pg8::EpiSwiGLU, pg8::StaticOrder, GALIGN, GSP2>(lds, g, S, E); }
#endif
            GSYNC();
#define ROWOP_FFN(row0_, nrows_, gw_, ngw_) do { const float* gl = p.norm_g + (size_t)layer * 6 * DM; const float* modl = (const float*)(ws + WS_MOD) + (size_t)layer * 9 * NMOD; \
              if (half == 0) rowop_rows<false, true, true>(p, row0_, nrows_, gw_, ngw_, 0.5f, modl, 2, gl + 1 * DM, modl, 3, gl + 2 * DM); \
              else if (layer < 3) rowop_rows<false, true, true>(p, row0_, nrows_, gw_, ngw_, 0.5f, modl, 8, gl + 5 * DM, modl + 9 * NMOD, 0, gl + 6 * DM); \
              else rowop_rows<false, true, false>(p, row0_, nrows_, gw_, ngw_, 0.5f, modl, 8, gl + 5 * DM, nullptr, 0, nullptr); } while (0)
            { const bool wctx = (half == 0 || layer < 3);
#pragma unroll 1
              for (int pass = 0; pass < (wctx ? 2 : 1); ++pass) {
                  if (pass == 0 || (int)bid_opaque() < 32) {
#ifndef NO_G2
                      { LOADP();
                        pg8::Gemm g{(const bf16*)(ws + WS_U) + (pass ? (size_t)NL * DFF : 0), (const bf16*)(ws + WS_FOUT + (size_t)(layer * 2 + half) * FOUT_BYTES), pass ? NC : NL, 1024, DFF};
                        pg8::EpiBf16S E{(bf16*)(ws + WS_Y) + (pass ? (size_t)NL * DM : 0), 1024};
                        pg8::StaticOrder S; S.init(g.M, g.N, pass ? 32 : G, (int)bid_opaque());
                        pg8::gemm_phase<pg8::EpiBf16S, pg8::StaticOrder, GALIGN, GSP2>(lds, g, S, E); }
#endif
                  } else { LOADP(); ROWOP_FFN(0, NL, ((int)bid_opaque() - 32) * 8 + (tid_opaque() >> 6), (G - 32) * 8); }
                  GSYNC();
              }
              { LOADP(); if (wctx) ROWOP_FFN(NL, NC, (int)bid_opaque() * 8 + (tid_opaque() >> 6), G * 8); else ROWOP_FFN(0, NL, (int)bid_opaque() * 8 + (tid_opaque() >> 6), G * 8); }
              if (!(layer == 3 && half == 1)) GSYNC();
            }
#undef ROWOP_FFN
        }
    }
}

extern "C" void kernel_launch(void* const* d_in, const int* in_sizes, int n_in, void* d_out, int out_size, void* d_ws, size_t ws_size, hipStream_t stream) {
    static int grid_blocks = 0;
    if (grid_blocks == 0) {
        if (n_in != 26 || out_size != NL * DM || ws_size < WS_END) { fprintf(stderr, "kernel_launch: unexpected shapes (n_in %d, out %d, ws %zu)\n", n_in, out_size, ws_size); grid_blocks = -1; return; }
        int dev = 0, cus = 0, per_cu = 0;
        hipGetDevice(&dev);
        hipDeviceGetAttribute(&cus, hipDeviceAttributeMultiprocessorCount, dev);
        if (hipFuncSetAttribute((const void*)fwd_megakernel, hipFuncAttributeMaxDynamicSharedMemorySize, LDS_BYTES) != hipSuccess) { fprintf(stderr, "kernel_launch: hipFuncSetAttribute failed\n"); grid_blocks = -1; return; }
        if (hipOccupancyMaxActiveBlocksPerMultiprocessor(&per_cu, (const void*)fwd_megakernel, NTHREADS, LDS_BYTES) != hipSuccess || per_cu < 1) { fprintf(stderr, "kernel_launch: occupancy query failed (%d)\n", per_cu); per_cu = 1; (void)hipGetLastError(); }
        grid_blocks = cus * (per_cu > 1 ? 1 : per_cu);
    }
    if (grid_blocks < 0) return;
    Params p{};
    const float** pp = (const float**)&p;
    for (int i = 0; i < 26; ++i) pp[i] = (const float*)d_in[i];
    p.out = (float*)d_out; p.ws = (unsigned char*)d_ws;
    if (hipMemsetAsync((char*)d_ws + WS_BAR, 0, XCD_BAR_WORDS * 4, stream) != hipSuccess) { fprintf(stderr, "kernel_launch: memset failed\n"); return; }
    void* args[] = {&p};
    hipError_t e = hipLaunchCooperativeKernel((const void*)fwd_megakernel, dim3(grid_blocks), dim3(NTHREADS), args, LDS_BYTES, stream);
    if (e != hipSuccess) fprintf(stderr, "cooperative launch failed: %s (grid %d)\n", hipGetErrorString(e), grid_blocks);
}
```
